# Optimizing an MI355X kernel written in HIP

```python
import math
import jax, jax.numpy as jnp
from jax import lax
import numpy as np

D_MODEL = 2048
BATCH = 4
SEQ = 2048
DEPTH = 1
DEC_BATCH = 128
DEC_SEQ = 8
PAST_LEN = 16384
PAGE_SIZE = 128

PLE_DIM = 256
S5_GROUP = 16
S5_WIDTH = D_MODEL // 2
S5_GROUPS = S5_WIDTH // S5_GROUP
S5_STATE = 64
DN_HEAD_DIM = 128
DN_WIDTH = D_MODEL // 2
DN_HEADS = DN_WIDTH // DN_HEAD_DIM
CONV_WIDTH = 4
CONV_CH = 3 * DN_WIDTH
CHUNK = 64
D_FF = ((-(-(8 * D_MODEL) // 3) + 255) // 256) * 256
OFF_U = S5_WIDTH
OFF_QKV = OFF_U + CONV_CH
OFF_Z = OFF_QKV + DN_WIDTH
OFF_BETA = OFF_Z + DN_HEADS
OFF_A = OFF_BETA + DN_HEADS
OFF_GA = OFF_A + D_MODEL
N_IN = OFF_GA + D_MODEL
EPS = 1e-6

kernel_name = "hybrid_s5_gdn_parallel_decode_step"


def rms_norm(x, g):
    xf = x.astype(jnp.float32)
    y = xf * lax.rsqrt(jnp.mean(xf * xf, axis=-1, keepdims=True) + EPS)
    return (y * g.astype(jnp.float32)).astype(x.dtype)


def l2_norm(x):
    return x * lax.rsqrt(jnp.sum(x * x, axis=-1, keepdims=True) + EPS)


def causal_conv_silu(xc, buf, w):
    L = xc.shape[1]
    xp = jnp.concatenate([buf.astype(xc.dtype), xc], axis=1)
    out = xp[:, 0:L] * w[0]
    for j in range(1, CONV_WIDTH):
        out = out + xp[:, j:j + L] * w[j]
    return jax.nn.silu(out), xp[:, L:]


def s5_mixer(u, h0_re, h0_im, a_re, a_im, b_re, b_im, c_re, c_im, d, log_dt):
    f32 = jnp.float32
    Bsz, L, _ = u.shape
    uf = u.astype(f32)
    ug = uf.reshape(Bsz, L, S5_GROUPS, S5_GROUP)
    dt = jnp.exp(log_dt.astype(f32))[:, None]
    ar = a_re.astype(f32)
    ai = a_im.astype(f32)
    mag = jnp.exp(ar * dt)
    lb_re = mag * jnp.cos(ai * dt)
    lb_im = mag * jnp.sin(ai * dt)
    nr = lb_re - 1.0
    ni = lb_im
    den = ar * ar + ai * ai
    cr = (nr * ar + ni * ai) / den
    ci = (ni * ar - nr * ai) / den
    br = b_re.astype(f32)
    bi = b_im.astype(f32)
    bb_re = cr[..., None] * br - ci[..., None] * bi
    bb_im = cr[..., None] * bi + ci[..., None] * br
    bu_re = jnp.einsum('blgp,gnp->blgn', ug, bb_re)
    bu_im = jnp.einsum('blgp,gnp->blgn', ug, bb_im)
    h0r = h0_re.astype(f32)
    h0i = h0_im.astype(f32)
    bu_re = bu_re.at[:, 0].add(lb_re * h0r - lb_im * h0i)
    bu_im = bu_im.at[:, 0].add(lb_re * h0i + lb_im * h0r)
    a_r = jnp.broadcast_to(lb_re, bu_re.shape)
    a_i = jnp.broadcast_to(lb_im, bu_im.shape)

    def combine(e1, e2):
        a1r, a1i, b1r, b1i = e1
        a2r, a2i, b2r, b2i = e2
        return (a2r * a1r - a2i * a1i,
                a2r * a1i + a2i * a1r,
                a2r * b1r - a2i * b1i + b2r,
                a2r * b1i + a2i * b1r + b2i)

    _, _, hr, hi = lax.associative_scan(combine, (a_r, a_i, bu_re, bu_im), axis=1)
    y = (jnp.einsum('blgn,gpn->blgp', hr, c_re.astype(f32))
         - jnp.einsum('blgn,gpn->blgp', hi, c_im.astype(f32)))
    y = y.reshape(Bsz, L, S5_WIDTH) + d.astype(f32) * uf
    return y, hr[:, -1], hi[:, -1]


def gated_delta_rule(q, k, v, g, beta, S0):
    Bsz, L, H, DK = q.shape
    DV = v.shape[-1]
    C = min(CHUNK, L)
    n = -(-L // C)
    pad = n * C - L
    if pad:
        p4 = ((0, 0), (0, pad), (0, 0), (0, 0))
        p3 = ((0, 0), (0, pad), (0, 0))
        q = jnp.pad(q, p4)
        k = jnp.pad(k, p4)
        v = jnp.pad(v, p4)
        g = jnp.pad(g, p3)
        beta = jnp.pad(beta, p3)

    def to_chunks(t):
        t = t.reshape((Bsz, n, C) + t.shape[2:])
        return jnp.moveaxis(t, (1, 3), (0, 2))

    qc = to_chunks(q)
    kc = to_chunks(k)
    vc = to_chunks(v)
    bc = to_chunks(beta)
    gc = jnp.cumsum(to_chunks(g), axis=-1)
    idx = jnp.arange(C)
    incl = idx[:, None] >= idx[None, :]
    strict = idx[:, None] > idx[None, :]
    decay = jnp.exp(jnp.where(incl, gc[..., :, None] - gc[..., None, :], -jnp.inf))
    kk = jnp.einsum('nbhid,nbhjd->nbhij', kc, kc)
    lower = jnp.where(strict, bc[..., :, None] * kk * decay, 0.0)
    eye = jnp.eye(C, dtype=jnp.float32)
    tmat = lax.linalg.triangular_solve(eye + lower, jnp.broadcast_to(eye, lower.shape),
                                       left_side=True, lower=True)
    u = tmat @ (vc * bc[..., None])
    w = tmat @ (kc * (bc * jnp.exp(gc))[..., None])
    qk = jnp.einsum('nbhid,nbhjd->nbhij', qc, kc) * decay

    def step(S, xs):
        q_i, k_i, u_i, w_i, qk_i, g_i = xs
        v_new = u_i - jnp.einsum('bhcd,bhde->bhce', w_i, S)
        o = (jnp.einsum('bhcd,bhde->bhce', q_i * jnp.exp(g_i)[..., None], S)
             + jnp.einsum('bhij,bhje->bhie', qk_i, v_new))
        g_last = g_i[..., -1:]
        S = (S * jnp.exp(g_last)[..., None]
             + jnp.einsum('bhcd,bhce->bhde', k_i * jnp.exp(g_last - g_i)[..., None], v_new))
        return S, o

    S, o = lax.scan(step, S0, (qc, kc, u, w, qk, gc))
    o = jnp.moveaxis(o, (0, 2), (1, 3)).reshape(Bsz, n * C, H, DV)[:, :L]
    return o, S


def deltanet_mixer(qkv, z, beta_l, a_l, conv_buf, S0, conv_w, a_log, dt_bias, onorm_w):
    f32 = jnp.float32
    qkv, conv_new = causal_conv_silu(qkv, conv_buf, conv_w)
    Bsz, L, _ = qkv.shape
    qkv = qkv.astype(f32)
    q = qkv[..., :DN_WIDTH].reshape(Bsz, L, DN_HEADS, DN_HEAD_DIM)
    k = qkv[..., DN_WIDTH:2 * DN_WIDTH].reshape(Bsz, L, DN_HEADS, DN_HEAD_DIM)
    v = qkv[..., 2 * DN_WIDTH:].reshape(Bsz, L, DN_HEADS, DN_HEAD_DIM)
    q = l2_norm(q) * (DN_HEAD_DIM ** -0.5)
    k = l2_norm(k)
    beta = jax.nn.sigmoid(beta_l.astype(f32))
    g = -jnp.exp(a_log.astype(f32)) * jax.nn.softplus(a_l.astype(f32) + dt_bias.astype(f32))
    o, S_new = gated_delta_rule(q, k, v, g, beta, S0.astype(f32))
    o = o * lax.rsqrt(jnp.mean(o * o, axis=-1, keepdims=True) + EPS) * onorm_w.astype(f32)
    o = o * jax.nn.silu(z.astype(f32).reshape(Bsz, L, DN_HEADS, DN_HEAD_DIM))
    return o.reshape(Bsz, L, DN_WIDTH), conv_new, S_new


def decoder_layer(x, p, conv_buf, S0, h_re, h_im, lw):
    dtype = x.dtype
    h = rms_norm(x, lw['g_mix'])
    proj = h @ lw['w_in']
    u = proj[..., :OFF_U]
    qkv = proj[..., OFF_U:OFF_QKV]
    z = proj[..., OFF_QKV:OFF_Z]
    beta_l = proj[..., OFF_Z:OFF_BETA]
    a_l = proj[..., OFF_BETA:OFF_A]
    gate_a = proj[..., OFF_A:OFF_GA]
    gate_b = proj[..., OFF_GA:]
    y_s5, hr_new, hi_new = s5_mixer(u, h_re, h_im, lw['s5_a_re'], lw['s5_a_im'], lw['s5_b_re'],
                                    lw['s5_b_im'], lw['s5_c_re'], lw['s5_c_im'], lw['s5_d'], lw['s5_log_dt'])
    y_s5 = jax.nn.gelu(y_s5).astype(dtype)
    y_s5 = y_s5 * jax.nn.sigmoid(y_s5 @ lw['w_glu'] + lw['b_glu'])
    y_dn, conv_new, S_new = deltanet_mixer(qkv, z, beta_l, a_l, conv_buf, S0, lw['conv_w'],
                                           lw['a_log'], lw['dt_bias'], lw['onorm_w'])
    y_dn = y_dn.astype(dtype)
    mix = jax.nn.sigmoid(gate_a) * (y_s5 @ lw['w_a']) + jax.nn.sigmoid(gate_b) * (y_dn @ lw['w_b'])
    x = x + mix @ lw['w_out']
    h2 = rms_norm(x, lw['g_ffn'])
    x = x + (jax.nn.silu(h2 @ lw['w_gate']) * (h2 @ lw['w_up'])) @ lw['w_down']
    h3 = rms_norm(x, lw['g_ple'])
    x = x + (p.astype(dtype) @ lw['w_ple']) * jax.nn.sigmoid(h3 @ lw['w_ple_gate'])
    return x, conv_new.astype(dtype), S_new.astype(dtype), hr_new.astype(dtype), hi_new.astype(dtype)


def setup_inputs(seed: int = 0) -> dict:
    key = jax.random.key(seed)
    ks = list(jax.random.split(key, 48))
    f32 = jnp.float32

    def nrm(shape, scale):
        return jax.random.normal(ks.pop(), shape, f32) * scale

    def unif(shape, lo, hi):
        return jax.random.uniform(ks.pop(), shape, f32, lo, hi)

    out = {}
    out['x_prompt'] = nrm((BATCH, SEQ, D_MODEL), 1.0)
    out['x_sample'] = nrm((DEC_BATCH, DEC_SEQ, D_MODEL), 1.0)
    out['state_conv'] = nrm((DEPTH, DEC_BATCH, CONV_WIDTH - 1, CONV_CH), 1.0)
    out['state_delta'] = nrm((DEPTH, DEC_BATCH, DN_HEADS, DN_HEAD_DIM, DN_HEAD_DIM), 0.1)
    out['state_s5_re'] = nrm((DEPTH, DEC_BATCH, S5_GROUPS, S5_STATE), 0.5)
    out['state_s5_im'] = nrm((DEPTH, DEC_BATCH, S5_GROUPS, S5_STATE), 0.5)
    out['p_prompt'] = nrm((DEPTH, BATCH, SEQ, PLE_DIM), 1.0)
    out['p_sample'] = nrm((DEPTH, DEC_BATCH, DEC_SEQ, PLE_DIM), 1.0)
    out['g_mix'] = 1.0 + nrm((DEPTH, D_MODEL), 0.02)
    out['w_in'] = nrm((DEPTH, D_MODEL, N_IN), D_MODEL ** -0.5)
    out['conv_w'] = nrm((DEPTH, CONV_WIDTH, CONV_CH), CONV_WIDTH ** -0.5)
    out['a_log'] = jnp.log(unif((DEPTH, DN_HEADS), 1.0, 16.0))
    dt = jnp.exp(unif((DEPTH, DN_HEADS), math.log(1e-3), math.log(1e-1)))
    out['dt_bias'] = dt + jnp.log(-jnp.expm1(-dt))
    out['onorm_w'] = 1.0 + nrm((DEPTH, DN_HEAD_DIM), 0.02)
    out['s5_a_re'] = -0.5 + nrm((DEPTH, S5_GROUPS, S5_STATE), 0.01)
    out['s5_a_im'] = jnp.pi * jnp.arange(S5_STATE, dtype=f32) + nrm((DEPTH, S5_GROUPS, S5_STATE), 0.01)
    out['s5_b_re'] = nrm((DEPTH, S5_GROUPS, S5_STATE, S5_GROUP), (2 * S5_GROUP) ** -0.5)
    out['s5_b_im'] = nrm((DEPTH, S5_GROUPS, S5_STATE, S5_GROUP), (2 * S5_GROUP) ** -0.5)
    out['s5_c_re'] = nrm((DEPTH, S5_GROUPS, S5_GROUP, S5_STATE), (2 * S5_STATE) ** -0.5)
    out['s5_c_im'] = nrm((DEPTH, S5_GROUPS, S5_GROUP, S5_STATE), (2 * S5_STATE) ** -0.5)
    out['s5_d'] = nrm((DEPTH, S5_WIDTH), 1.0)
    out['s5_log_dt'] = unif((DEPTH, S5_GROUPS), math.log(1e-3), math.log(1e-1))
    out['w_glu'] = nrm((DEPTH, S5_WIDTH, S5_WIDTH), S5_WIDTH ** -0.5)
    out['b_glu'] = nrm((DEPTH, S5_WIDTH), 0.01)
    out['w_a'] = nrm((DEPTH, S5_WIDTH, D_MODEL), S5_WIDTH ** -0.5)
    out['w_b'] = nrm((DEPTH, DN_WIDTH, D_MODEL), DN_WIDTH ** -0.5)
    out['w_out'] = nrm((DEPTH, D_MODEL, D_MODEL), D_MODEL ** -0.5)
    out['g_ffn'] = 1.0 + nrm((DEPTH, D_MODEL), 0.02)
    out['w_gate'] = nrm((DEPTH, D_MODEL, D_FF), D_MODEL ** -0.5)
    out['w_up'] = nrm((DEPTH, D_MODEL, D_FF), D_MODEL ** -0.5)
    out['w_down'] = nrm((DEPTH, D_FF, D_MODEL), D_FF ** -0.5)
    out['g_ple'] = 1.0 + nrm((DEPTH, D_MODEL), 0.02)
    out['w_ple'] = nrm((DEPTH, PLE_DIM, D_MODEL), PLE_DIM ** -0.5)
    out['w_ple_gate'] = nrm((DEPTH, D_MODEL, D_MODEL), D_MODEL ** -0.5)
    out['g_final'] = 1.0 + nrm((D_MODEL,), 0.02)
    return out


def reference(x_prompt, x_sample, state_conv, state_delta, state_s5_re, state_s5_im, p_prompt, p_sample,
              g_mix, w_in, conv_w, a_log, dt_bias, onorm_w, s5_a_re, s5_a_im, s5_b_re, s5_b_im,
              s5_c_re, s5_c_im, s5_d, s5_log_dt, w_glu, b_glu, w_a, w_b, w_out, g_ffn, w_gate, w_up,
              w_down, g_ple, w_ple, w_ple_gate, g_final):
    dt_x = x_prompt.dtype
    zc = jnp.zeros((BATCH, CONV_WIDTH - 1, CONV_CH), dt_x)
    zd = jnp.zeros((BATCH, DN_HEADS, DN_HEAD_DIM, DN_HEAD_DIM), dt_x)
    zs = jnp.zeros((BATCH, S5_GROUPS, S5_STATE), dt_x)
    yp = x_prompt
    ys = x_sample
    pc, pd, pr, pi_ = [], [], [], []
    sc, sd, sr, si = [], [], [], []
    for i in range(DEPTH):
        lw = dict(g_mix=g_mix[i], w_in=w_in[i], conv_w=conv_w[i], a_log=a_log[i], dt_bias=dt_bias[i],
                  onorm_w=onorm_w[i], s5_a_re=s5_a_re[i], s5_a_im=s5_a_im[i], s5_b_re=s5_b_re[i],
                  s5_b_im=s5_b_im[i], s5_c_re=s5_c_re[i], s5_c_im=s5_c_im[i], s5_d=s5_d[i],
                  s5_log_dt=s5_log_dt[i], w_glu=w_glu[i], b_glu=b_glu[i], w_a=w_a[i], w_b=w_b[i],
                  w_out=w_out[i], g_ffn=g_ffn[i], w_gate=w_gate[i], w_up=w_up[i], w_down=w_down[i],
                  g_ple=g_ple[i], w_ple=w_ple[i], w_ple_gate=w_ple_gate[i])
        yp, c1, d1, r1, m1 = decoder_layer(yp, p_prompt[i], zc, zd, zs, zs, lw)
        ys, c2, d2, r2, m2 = decoder_layer(ys, p_sample[i], state_conv[i], state_delta[i],
                                           state_s5_re[i], state_s5_im[i], lw)
        pc.append(c1); pd.append(d1); pr.append(r1); pi_.append(m1)
        sc.append(c2); sd.append(d2); sr.append(r2); si.append(m2)
    y_prompt = rms_norm(yp, g_final)
    y_sample = rms_norm(ys, g_final)
    return (y_prompt, y_sample,
            jnp.stack(pc), jnp.stack(pd), jnp.stack(pr), jnp.stack(pi_),
            jnp.stack(sc), jnp.stack(sd), jnp.stack(sr), jnp.stack(si))
```

```cpp
#include <hip/hip_runtime.h>
#include <cstdio>
#include <cstdint>

#ifndef MK_N_LAUNCHES
#define MK_N_LAUNCHES 1
#endif

#define LAS __attribute__((address_space(3)))
typedef unsigned short bf16;
typedef short bf16x8 __attribute__((ext_vector_type(8)));
typedef float f32x4 __attribute__((ext_vector_type(4)));
typedef float f32x2 __attribute__((ext_vector_type(2)));
typedef unsigned u32x4 __attribute__((ext_vector_type(4)));
typedef unsigned u32x2 __attribute__((ext_vector_type(2)));
typedef __bf16 bf2_t __attribute__((ext_vector_type(2)));

constexpr int DM = 2048, TP = 8192, TS = 1024, TT = 9216, SEQ = 2048, NBP = 4, NSB = 128, LSM = 8;
constexpr int NIN = 9232, NPROJ = 9216, NINP = 9472, FF = 5632, PLE = 256;
constexpr int NG = 64, NH = 8, HD = 128, CONVC = 3072, NCH = 32;
constexpr float EPS = 1e-6f;

constexpr size_t MiB = 1u << 20;
constexpr size_t WS_CTL = 0, CTL_ZERO_BYTES = 1 * MiB;
constexpr size_t WS_WIN = 1 * MiB, WS_WGLU = 38 * MiB, WS_WA = 40 * MiB, WS_WB = 44 * MiB, WS_WOUT = 48 * MiB, WS_WGU = 56 * MiB, WS_WDOWN = 100 * MiB, WS_WPLE = 122 * MiB, WS_WPG = 123 * MiB;
constexpr size_t WS_BA = 131 * MiB, WS_GL = 131 * MiB + 768 * 1024, WS_PB = 132 * MiB, WS_E = 137 * MiB;
constexpr size_t WS_HB = 141 * MiB, WS_YG = 141 * MiB, WS_YS = 159 * MiB, WS_X2G = 141 * MiB;
constexpr size_t WS_PROJ = 177 * MiB, WS_X1 = 177 * MiB, WS_X1G = 249 * MiB, WS_ACT = 285 * MiB, WS_TPLE = 285 * MiB;
constexpr size_t WS_YCAT = 1 * MiB;
constexpr size_t WS_SLAB = 1 * MiB;
constexpr size_t WS_O = 339 * MiB, WS_MIX = 339 * MiB, WS_YDN = 375 * MiB, WS_END = 393 * MiB;
constexpr int CW_BAR = 4096;
constexpr int CW_SSQ1 = 65536, CW_SSQ2 = 81920, CW_SSQ3 = 98304;
constexpr size_t O_Y = 0, O_CONVP = 18874368, O_DELTAP = 18911232, O_S5RP = 19435520, O_S5IP = 19451904, O_CONVS = 19468288, O_DELTAS = 20647936, O_S5RS = 37425152, O_S5IS = 37949440, O_END = 38473728;
constexpr size_t DN_ITEM = 73728, DN_W = 0, DN_QG = 16384, DN_KGT = 32768, DN_QK = 49152, DN_U = 57344;

constexpr int RING_BYTES = 131072, MISC_OFF = RING_BYTES + 320, LDS_BYTES = 147456;

__device__ __forceinline__ unsigned pk2(float a, float b) { bf2_t v; v.x = (__bf16)a; v.y = (__bf16)b; return __builtin_bit_cast(unsigned, v); }
__device__ __forceinline__ float bflo(unsigned w) { return __builtin_bit_cast(float, w << 16); }
__device__ __forceinline__ float bfhi(unsigned w) { return __builtin_bit_cast(float, w & 0xffff0000u); }
__device__ __forceinline__ float bf2f(bf16 h) { return __builtin_bit_cast(float, (unsigned)h << 16); }
__device__ __forceinline__ float sigmoidf_(float x) { return 1.f / (1.f + __expf(-x)); }
__device__ __forceinline__ float siluf_(float x) { return x / (1.f + __expf(-x)); }
__device__ __forceinline__ float gelu_tanh(float x) { const float z = 0.7978845608028654f * (x + 0.044715f * x * x * x); return x * __builtin_amdgcn_rcpf(1.f + __expf(-2.f * z)); }
__device__ __forceinline__ int permk(int x) { return (x & ~31) | (8 * ((x >> 2) & 3) + 4 * ((x >> 4) & 1) + (x & 3)); }
#define LDS_WAIT() asm volatile("s_waitcnt lgkmcnt(0)" ::: "memory")

struct Args {
    const float* in[35]; float* out; unsigned char* ws; int ph_lo, ph_hi, li, pad;
};
enum { I_XP = 0, I_XS, I_SCONV, I_SDELTA, I_S5RE, I_S5IM, I_PP, I_PS, I_GMIX, I_WIN, I_CONVW, I_ALOG, I_DTB, I_ONORM, I_S5AR, I_S5AI, I_S5BR, I_S5BI, I_S5CR, I_S5CI, I_S5D, I_S5LDT,
       I_WGLU, I_BGLU, I_WA, I_WB, I_WOUT, I_GFFN, I_WGATE, I_WUP, I_WDOWN, I_GPLE, I_WPLE, I_WPG, I_GFIN };

namespace pg8 {
constexpr int BM = 256, BK = 64, HALF = 128, HTB = HALF * BK * 2, NXCD = 8, WGM = 8;
__host__ __device__ __forceinline__ int lds_byte(int r, int c) { const int st = (r >> 4) * 2 + (c >> 5), rr = r & 15, cc = c & 31, ob = rr * 64 + cc * 2; return st * 1024 + (ob ^ (((ob >> 9) & 1) << 5)); }
__host__ __device__ __forceinline__ void stage_rc(int b, int& R, int& C) { const int st = b / 1024, sb = b % 1024, swz = sb ^ (((sb >> 9) & 1) << 5); R = (st >> 1) * 16 + swz / 64; C = (st & 1) * 32 + (swz % 64) / 2; }
__host__ __device__ __forceinline__ int perm32(int rho) { const int n = rho >> 4, i = rho & 15; return 8 * (i >> 2) + 4 * n + (i & 3); }
struct Unit { int pm, pn; };
struct Gemm { const bf16* A; const bf16* Bt; int M, N, K; int ld; };
struct StaticOrder {
    int nM, nN, nwg, G, c;
    __host__ __device__ void init(int M, int N, int G_, int c_) { nM = M / BM; nN = N / BM; nwg = nM * nN; G = G_; c = c_; }
    __host__ __device__ bool next(int i, Unit& u) const {
        const long L = (long)i * G + c; if (L >= nwg) return false;
        int wgid = (int)L; { const int q = nwg / NXCD, r = nwg % NXCD, xcd = wgid % NXCD, off = wgid / NXCD; wgid = (xcd < r ? xcd * (q + 1) : r * (q + 1) + (xcd - r) * q) + off; }
        const int nig = WGM * nN, gid = wgid / nig, fm = gid * WGM, gsz = (nM - fm) < WGM ? (nM - fm) : WGM;
        u.pm = fm + ((wgid % nig) % gsz); u.pn = (wgid % nig) / gsz; return true;
    }
    __device__ __forceinline__ void a_ready(const Unit&) const {}
    __device__ __forceinline__ void done(const Unit&) const {}
};

template <class Epi, class Sched, bool ALIGN_EPI = true, bool SP2 = true>
__device__ __forceinline__ void gemm_phase(LAS unsigned char* lds, const Gemm g, const Sched& S, const Epi& E) {
    int tid = threadIdx.x; asm volatile("" : "+v"(tid));
    const int wid = __builtin_amdgcn_readfirstlane(tid >> 6), lane = tid & 63, wr = wid >> 2, wc = wid & 3, fr = lane & 15, fq = lane >> 4;
    const int K = g.ld ? g.ld : g.K, nt = g.K / BK;
    unsigned voffA[2], voffB[2];
#pragma unroll
    for (int i = 0; i < 2; ++i) { int R, C; stage_rc(tid * 16 + i * 8192, R, C); const int Rb = Epi::PERM ? ((R & ~31) + perm32(R & 31)) : R;
        voffA[i] = (unsigned)(R * K + C) * 2u; voffB[i] = (unsigned)(Rb * K + C) * 2u; }
    const size_t kstep = (size_t)(BK * 2);
    const size_t hstep = (size_t)HALF * K * 2;
    const size_t tstep = 2 * hstep;
    const unsigned ldsw = (unsigned)wid * 1024u;
    const int aoff = lds_byte(wr * 64 + fr, fq * 8), boff = lds_byte(wc * 32 + fr, fq * 8);
#define PG8_SA(b, h) (((b) * 2 + (h)) * HTB)
#define PG8_SB(b, h) ((4 + (b) * 2 + (h)) * HTB)
#define PG8_STAGE(bufoff, gbase, voff) do { _Pragma("unroll") for (int _i = 0; _i < 2; ++_i) \
        __builtin_amdgcn_global_load_lds((const unsigned*)((const char*)(gbase) + (voff)[_i]), (LAS unsigned*)(lds + (bufoff) + ldsw + _i * 8192), 16, 0, 0); } while (0)
#define PG8_LDA(dst, b, h) do { _Pragma("unroll") for (int m = 0; m < 4; ++m) _Pragma("unroll") for (int k = 0; k < 2; ++k) dst[m][k] = *(const LAS bf16x8*)(lds + PG8_SA(b, h) + aoff + m * 2048 + k * 1024); } while (0)
#define PG8_LDB(dst, b, h) do { _Pragma("unroll") for (int n = 0; n < 2; ++n) _Pragma("unroll") for (int k = 0; k < 2; ++k) dst[n][k] = *(const LAS bf16x8*)(lds + PG8_SB(b, h) + boff + n * 2048 + k * 1024); } while (0)
#define PG8_MMA(ai, bj, At, Bt) do { __builtin_amdgcn_s_setprio(1); _Pragma("unroll") for (int m = 0; m < 4; ++m) _Pragma("unroll") for (int n = 0; n < 2; ++n) _Pragma("unroll") for (int k = 0; k < 2; ++k) \
        acc[ai][bj][m][n] = __builtin_amdgcn_mfma_f32_16x16x32_bf16(Bt[n][k], At[m][k], acc[ai][bj][m][n], 0, 0, 0); __builtin_amdgcn_s_setprio(0); } while (0)
#define PG8_WAIT_V(n) asm volatile("s_waitcnt vmcnt(" #n ")" ::: "memory")
#define PG8_WAIT_L(n) asm volatile("s_waitcnt lgkmcnt(" #n ")" ::: "memory")
#define PG8_BAR __builtin_amdgcn_s_barrier()
#define PG8_SCHED __builtin_amdgcn_sched_barrier(0)
    Unit cur, nxt; int ui = 0;
    if (!S.next(0, cur)) return;
    f32x4 acc[2][2][4][2];
#pragma unroll
    for (int a = 0; a < 2; ++a)
#pragma unroll
        for (int b = 0; b < 2; ++b)
#pragma unroll
            for (int m = 0; m < 4; ++m)
#pragma unroll
                for (int n = 0; n < 2; ++n) acc[a][b][m][n] = (f32x4){0.f, 0.f, 0.f, 0.f};
    bf16x8 At[4][2], B0[2][2], B1[2][2];
    const char* cA = (const char*)g.A + (size_t)cur.pm * tstep; const char* cB = (const char*)g.Bt + (size_t)cur.pn * tstep;
    S.a_ready(cur);
    if constexpr (SP2) {
        PG8_STAGE(PG8_SB(0, 0), cB, voffB); PG8_STAGE(PG8_SB(0, 1), cB + hstep, voffB); PG8_STAGE(PG8_SA(0, 0), cA, voffA); PG8_STAGE(PG8_SA(0, 1), cA + hstep, voffA);
        if (wr == 1) PG8_BAR;
        PG8_WAIT_V(2); PG8_BAR;
        PG8_STAGE(PG8_SB(1, 0), cB + kstep, voffB); PG8_STAGE(PG8_SA(1, 0), cA + kstep, voffA); PG8_STAGE(PG8_SB(1, 1), cB + hstep + kstep, voffB);
        PG8_WAIT_V(6); PG8_BAR;
    } else {
        PG8_STAGE(PG8_SB(0, 0), cB, voffB); PG8_STAGE(PG8_SA(0, 0), cA, voffA); PG8_STAGE(PG8_SB(0, 1), cB + hstep, voffB); PG8_STAGE(PG8_SA(0, 1), cA + hstep, voffA);
        if (wr == 1) PG8_BAR;
        PG8_WAIT_V(4); PG8_BAR;
        PG8_STAGE(PG8_SB(1, 0), cB + kstep, voffB); PG8_STAGE(PG8_SA(1, 0), cA + kstep, voffA); PG8_STAGE(PG8_SB(1, 1), cB + hstep + kstep, voffB);
        PG8_WAIT_V(6); PG8_BAR;
    }
    for (;;) {
        const bool has_next = S.next(ui + 1, nxt);
        const char* nA = has_next ? (const char*)g.A + (size_t)nxt.pm * tstep : cA; const char* nB = has_next ? (const char*)g.Bt + (size_t)nxt.pn * tstep : cB;
        for (int t = 0; t < nt; t += 2) {
            const bool last = (t == nt - 2);
            const char* a1 = cA + (size_t)(t + 1) * kstep;
            const char* a2 = last ? nA : cA + (size_t)(t + 2) * kstep; const char* b2 = last ? nB : cB + (size_t)(t + 2) * kstep;
            const char* a3 = a2 + kstep; const char* b3 = b2 + kstep;
            if (last && has_next) S.a_ready(nxt);
            if constexpr (Epi::MID_T >= 0) { if (t == Epi::MID_T) E.mid(acc, cur, wr, wc, fr, fq); }
            if constexpr (SP2) {
            PG8_LDB(B0, 0, 0); PG8_LDB(B1, 0, 1); PG8_SCHED; PG8_LDA(At, 0, 0); PG8_STAGE(PG8_SA(1, 1), a1 + hstep, voffA);
            PG8_WAIT_V(8); PG8_WAIT_L(0); PG8_BAR; PG8_MMA(0, 0, At, B0); PG8_MMA(0, 1, At, B1); PG8_BAR; PG8_SCHED;
            PG8_LDA(At, 0, 1); PG8_STAGE(PG8_SB(0, 0), b2, voffB); PG8_STAGE(PG8_SB(0, 1), b2 + hstep, voffB); PG8_STAGE(PG8_SA(0, 0), a2, voffA);
            PG8_WAIT_V(8); PG8_WAIT_L(0); PG8_BAR; PG8_MMA(1, 0, At, B0); PG8_MMA(1, 1, At, B1); PG8_BAR; PG8_SCHED;
            PG8_LDB(B0, 1, 0); PG8_LDB(B1, 1, 1); PG8_SCHED; PG8_LDA(At, 1, 0); PG8_STAGE(PG8_SA(0, 1), a2 + hstep, voffA);
            PG8_WAIT_V(8); PG8_WAIT_L(0); PG8_BAR; PG8_MMA(0, 0, At, B0); PG8_MMA(0, 1, At, B1); PG8_BAR; PG8_SCHED;
            PG8_LDA(At, 1, 1); PG8_STAGE(PG8_SB(1, 0), b3, voffB); PG8_STAGE(PG8_SB(1, 1), b3 + hstep, voffB); PG8_STAGE(PG8_SA(1, 0), a3, voffA);
            PG8_WAIT_V(8); PG8_WAIT_L(0); PG8_BAR; PG8_MMA(1, 0, At, B0); PG8_MMA(1, 1, At, B1); PG8_BAR; PG8_SCHED;
            } else {
            PG8_LDB(B0, 0, 0); PG8_SCHED; PG8_LDA(At, 0, 0); PG8_STAGE(PG8_SA(1, 1), a1 + hstep, voffA);
            PG8_WAIT_L(8); PG8_BAR; PG8_WAIT_L(0); PG8_MMA(0, 0, At, B0); PG8_BAR; PG8_SCHED;
            PG8_LDB(B1, 0, 1); PG8_STAGE(PG8_SB(0, 0), b2, voffB);
            PG8_BAR; PG8_WAIT_L(0); PG8_MMA(0, 1, At, B1); PG8_BAR;
            PG8_LDA(At, 0, 1); PG8_STAGE(PG8_SA(0, 0), a2, voffA);
            PG8_BAR; PG8_WAIT_L(0); PG8_MMA(1, 0, At, B0); PG8_BAR; PG8_SCHED;
            PG8_STAGE(PG8_SB(0, 1), b2 + hstep, voffB);
            PG8_WAIT_V(6); PG8_BAR; PG8_MMA(1, 1, At, B1); PG8_BAR;
            PG8_LDB(B0, 1, 0); PG8_SCHED; PG8_LDA(At, 1, 0); PG8_STAGE(PG8_SA(0, 1), a2 + hstep, voffA);
            PG8_WAIT_L(8); PG8_BAR; PG8_WAIT_L(0); PG8_MMA(0, 0, At, B0); PG8_BAR; PG8_SCHED;
            PG8_LDB(B1, 1, 1); PG8_STAGE(PG8_SB(1, 0), b3, voffB);
            PG8_BAR; PG8_WAIT_L(0); PG8_MMA(0, 1, At, B1); PG8_BAR;
            PG8_LDA(At, 1, 1); PG8_STAGE(PG8_SA(1, 0), a3, voffA);
            PG8_BAR; PG8_WAIT_L(0); PG8_MMA(1, 0, At, B0); PG8_BAR; PG8_SCHED;
            PG8_STAGE(PG8_SB(1, 1), b3 + hstep, voffB);
            PG8_WAIT_V(6); PG8_BAR; PG8_MMA(1, 1, At, B1); PG8_BAR;
            }
        }
        if constexpr (ALIGN_EPI) { if (wr == 0) PG8_BAR; }
        E(acc, cur, wr, wc, fr, fq); S.done(cur);
        if (!has_next) break;
#pragma unroll
        for (int a = 0; a < 2; ++a)
#pragma unroll
            for (int b = 0; b < 2; ++b)
#pragma unroll
                for (int m = 0; m < 4; ++m)
#pragma unroll
                    for (int n = 0; n < 2; ++n) acc[a][b][m][n] = (f32x4){0.f, 0.f, 0.f, 0.f};
        cur = nxt; cA = nA; cB = nB; ++ui;
        if constexpr (ALIGN_EPI) { if (wr == 1) PG8_BAR; }
    }
    PG8_WAIT_V(0);
    if constexpr (!ALIGN_EPI) { if (wr == 0) PG8_BAR; }
    PG8_BAR;
#undef PG8_SA
#undef PG8_SB
#undef PG8_STAGE
#undef PG8_LDA
#undef PG8_LDB
#undef PG8_MMA
#undef PG8_WAIT_V
#undef PG8_WAIT_L
#undef PG8_BAR
#undef PG8_SCHED
}
}

typedef f32x4 AccT[2][2][4][2];
#define EPI_ROWS_BEGIN  _Pragma("unroll") for (int ai = 0; ai < 2; ++ai) _Pragma("unroll") for (int m = 0; m < 4; ++m) { const int row = u.pm * 256 + ai * 128 + wr * 64 + m * 16 + fr;
#define EPI_ROWS_END    asm volatile("" ::: "memory"); }
__device__ __forceinline__ u32x4 pack8(const f32x4 a, const f32x4 b) { u32x4 w; w.x = pk2(a[0], a[1]); w.y = pk2(a[2], a[3]); w.z = pk2(b[0], b[1]); w.w = pk2(b[2], b[3]); return w; }
__device__ __forceinline__ void unpack8(const u32x4 w, f32x4& a, f32x4& b) { a = (f32x4){bflo(w.x), bfhi(w.x), bflo(w.y), bfhi(w.y)}; b = (f32x4){bflo(w.z), bfhi(w.z), bflo(w.w), bfhi(w.w)}; }
__device__ __forceinline__ f32x4 sig4(f32x4 v) { return (f32x4){sigmoidf_(v[0]), sigmoidf_(v[1]), sigmoidf_(v[2]), sigmoidf_(v[3])}; }
__device__ __forceinline__ float ssq8(const f32x4 a, const f32x4 b) { return (a[0] * a[0] + a[1] * a[1]) + (a[2] * a[2] + a[3] * a[3]) + (b[0] * b[0] + b[1] * b[1]) + (b[2] * b[2] + b[3] * b[3]); }

struct EpiProj {
    static constexpr bool PERM = true; static constexpr int MID_T = -1;
    bf16* P; float* BA;
    __device__ __forceinline__ void operator()(const AccT& acc, const pg8::Unit& u, int wr, int wc, int fr, int fq) const {
        if (u.pn < 36) {
            const int col0 = u.pn * 256 + wc * 32 + 8 * fq;
            EPI_ROWS_BEGIN
                bf16* rp = P + (size_t)row * NPROJ + col0;
#pragma unroll
                for (int bj = 0; bj < 2; ++bj) *(u32x4*)(rp + bj * 128) = pack8(acc[ai][bj][m][0], acc[ai][bj][m][1]);
            EPI_ROWS_END
        } else if (wc == 0 && fq < 2) {
            EPI_ROWS_BEGIN
                float* rp = BA + (size_t)row * 16 + 8 * fq;
                *(f32x4*)rp = acc[ai][0][m][0]; *(f32x4*)(rp + 4) = acc[ai][0][m][1];
            EPI_ROWS_END
        }
    }
};
struct EpiGlu {
    static constexpr bool PERM = true; static constexpr int MID_T = -1;
    const bf16* YG; bf16* YS; const float* bias;
    __device__ __forceinline__ void operator()(const AccT& acc, const pg8::Unit& u, int wr, int wc, int fr, int fq) const {
        const int col0 = u.pn * 256 + wc * 32 + 8 * fq;
        f32x4 bv[2][2];
#pragma unroll
        for (int bj = 0; bj < 2; ++bj) { bv[bj][0] = *(const f32x4*)(bias + col0 + bj * 128); bv[bj][1] = *(const f32x4*)(bias + col0 + bj * 128 + 4); }
        EPI_ROWS_BEGIN
#pragma unroll
            for (int bj = 0; bj < 2; ++bj) { const size_t off = (size_t)row * 1024 + col0 + bj * 128;
                f32x4 y0, y1; unpack8(*(const u32x4*)(YG + off), y0, y1);
                const f32x4 o0 = y0 * sig4(acc[ai][bj][m][0] + bv[bj][0]), o1 = y1 * sig4(acc[ai][bj][m][1] + bv[bj][1]);
                *(u32x4*)(YS + (size_t)row * DM + col0 + bj * 128) = pack8(o0, o1); }
        EPI_ROWS_END
    }
};
struct EpiMix {
    static constexpr bool PERM = true; static constexpr int MID_T = 16;
    const bf16* P; bf16* MIX;
    __device__ __forceinline__ void mid(AccT& acc, const pg8::Unit& u, int wr, int wc, int fr_, int fq) const {
        int fr = fr_; asm volatile("" : "+v"(fr));
        const int col0 = u.pn * 256 + wc * 32 + 8 * fq;
        EPI_ROWS_BEGIN
            const bf16* gp = P + (size_t)row * NPROJ + 5120 + col0;
#pragma unroll
            for (int bj = 0; bj < 2; ++bj) {
                f32x4 a0, a1, b0, b1; unpack8(*(const u32x4*)(gp + bj * 128), a0, a1); unpack8(*(const u32x4*)(gp + 2048 + bj * 128), b0, b1);
#pragma unroll
                for (int q = 0; q < 4; ++q) { acc[ai][bj][m][0][q] *= (1.f + __expf(-b0[q])) * __builtin_amdgcn_rcpf(1.f + __expf(-a0[q])); acc[ai][bj][m][1][q] *= (1.f + __expf(-b1[q])) * __builtin_amdgcn_rcpf(1.f + __expf(-a1[q])); }
                asm volatile("" ::: "memory"); }
        EPI_ROWS_END
    }
    __device__ __forceinline__ void operator()(const AccT& acc, const pg8::Unit& u, int wr, int wc, int fr, int fq) const {
        const int col0 = u.pn * 256 + wc * 32 + 8 * fq;
        EPI_ROWS_BEGIN
#pragma unroll
            for (int bj = 0; bj < 2; ++bj) { const int c = col0 + bj * 128;
                f32x4 g0, g1; unpack8(*(const u32x4*)(P + (size_t)row * NPROJ + 7168 + c), g0, g1);
                *(u32x4*)(MIX + (size_t)row * DM + c) = pack8(sig4(g0) * acc[ai][bj][m][0], sig4(g1) * acc[ai][bj][m][1]); }
        EPI_ROWS_END
    }
};
struct EpiResid {
    static constexpr bool PERM = true; static constexpr int MID_T = -1;
    const float* b0; const float* b1; float* XO; bf16* XG; const float* gw; float* ssq;
    __device__ __forceinline__ void operator()(const AccT& acc, const pg8::Unit& u, int wr, int wc, int fr, int fq) const {
        const int col0 = u.pn * 256 + wc * 32 + 8 * fq;
        f32x4 gv[2][2];
#pragma unroll
        for (int bj = 0; bj < 2; ++bj) { gv[bj][0] = *(const f32x4*)(gw + col0 + bj * 128); gv[bj][1] = *(const f32x4*)(gw + col0 + bj * 128 + 4); }
        EPI_ROWS_BEGIN
            const float* bp = (row < TP ? b0 + (size_t)row * DM : b1 + (size_t)(row - TP) * DM) + col0;
            float s = 0.f;
#pragma unroll
            for (int bj = 0; bj < 2; ++bj) { const int c = col0 + bj * 128;
                const f32x4 o0 = *(const f32x4*)(bp + bj * 128) + acc[ai][bj][m][0], o1 = *(const f32x4*)(bp + bj * 128 + 4) + acc[ai][bj][m][1];
                float* xp = XO + (size_t)row * DM + c; *(f32x4*)xp = o0; *(f32x4*)(xp + 4) = o1;
                *(u32x4*)(XG + (size_t)row * DM + c) = pack8(o0 * gv[bj][0], o1 * gv[bj][1]);
                s += ssq8(o0, o1); }
            s += __shfl_xor(s, 16); s += __shfl_xor(s, 32);
            if (fq == 0) atomicAdd(ssq + row, s);
        EPI_ROWS_END
    }
};
struct EpiGU {
    static constexpr bool PERM = true; static constexpr int MID_T = -1;
    const float* ssq; bf16* ACT;
    __device__ __forceinline__ void operator()(const AccT& acc, const pg8::Unit& u, int wr, int wc, int fr, int fq) const {
        const int col0 = u.pn * 128 + wc * 32 + 8 * fq;
        EPI_ROWS_BEGIN
            const float rs = __builtin_amdgcn_rsqf(ssq[row] * (1.f / DM) + EPS);
            f32x4 o[2];
#pragma unroll
            for (int n = 0; n < 2; ++n) { const f32x4 g = acc[ai][0][m][n] * rs, up = acc[ai][1][m][n] * rs;
                o[n] = (f32x4){siluf_(g[0]) * up[0], siluf_(g[1]) * up[1], siluf_(g[2]) * up[2], siluf_(g[3]) * up[3]}; }
            *(u32x4*)(ACT + (size_t)row * FF + col0) = pack8(o[0], o[1]);
        EPI_ROWS_END
    }
};
struct EpiF32 {
    static constexpr bool PERM = true; static constexpr int MID_T = -1;
    float* C;
    __device__ __forceinline__ void operator()(const AccT& acc, const pg8::Unit& u, int wr, int wc, int fr, int fq) const {
        const int col0 = u.pn * 256 + wc * 32 + 8 * fq;
        EPI_ROWS_BEGIN
#pragma unroll
            for (int bj = 0; bj < 2; ++bj) { float* tp = C + (size_t)row * DM + col0 + bj * 128; *(f32x4*)tp = acc[ai][bj][m][0]; *(f32x4*)(tp + 4) = acc[ai][bj][m][1]; }
        EPI_ROWS_END
    }
};
struct TailOrder {
    int c;
    __device__ bool next(int i, pg8::Unit& u) const { if (i != 0) return false; u.pm = 32 + (c >> 6); u.pn = (c >> 3) & 7; return true; }
    __device__ __forceinline__ void a_ready(const pg8::Unit&) const {}
    __device__ __forceinline__ void done(const pg8::Unit&) const {}
};
struct EpiSlab {
    static constexpr bool PERM = true; static constexpr int MID_T = -1;
    float* C;
    __device__ __forceinline__ void operator()(const AccT& acc, const pg8::Unit& u, int wr, int wc, int fr, int fq) const {
        const int col0 = u.pn * 256 + wc * 32 + 8 * fq;
        EPI_ROWS_BEGIN
#pragma unroll
            for (int bj = 0; bj < 2; ++bj) { float* tp = C + (size_t)(row - TP) * DM + col0 + bj * 128; *(f32x4*)tp = acc[ai][bj][m][0]; *(f32x4*)(tp + 4) = acc[ai][bj][m][1]; }
        EPI_ROWS_END
    }
};
struct EpiPleB {
    static constexpr bool PERM = true; static constexpr int MID_T = -1;
    float* X; const float* TPLE; const float* ssq_in; float* ssq_out;
    __device__ __forceinline__ void operator()(const AccT& acc, const pg8::Unit& u, int wr, int wc, int fr, int fq) const {
        const int col0 = u.pn * 256 + wc * 32 + 8 * fq;
        EPI_ROWS_BEGIN
            const float rs = __builtin_amdgcn_rsqf(ssq_in[row] * (1.f / DM) + EPS);
            float s = 0.f;
            float* xp = X + (size_t)row * DM + col0; const float* tp = TPLE + (size_t)row * DM + col0;
#pragma unroll
            for (int bj = 0; bj < 2; ++bj) {
#pragma unroll
                for (int n = 0; n < 2; ++n) { const f32x4 o = *(const f32x4*)(xp + bj * 128 + 4 * n) + *(const f32x4*)(tp + bj * 128 + 4 * n) * sig4(acc[ai][bj][m][n] * rs);
                    *(f32x4*)(xp + bj * 128 + 4 * n) = o; s += (o[0] * o[0] + o[1] * o[1]) + (o[2] * o[2] + o[3] * o[3]); asm volatile("" ::: "memory"); } }
            s += __shfl_xor(s, 16); s += __shfl_xor(s, 32);
            if (fq == 0) atomicAdd(ssq_out + row, s);
        EPI_ROWS_END
    }
};

#define XB_TMO      128
#define XB_XCNT(j)  (256  + 64 * (j))
#define XB_XSUB(j)  (1280 + 64 * (j))
#define XB_XGEN(j)  (2304 + 64 * (j))
#define XB_TOP      3328
#define XB_TOPGEN   3392
#define XCD_BAR_WORDS 3456
#define XB_SPIN_CAP (1u << 20)
__device__ __forceinline__ unsigned xb_ld(unsigned* p)              { return __hip_atomic_load(p, __ATOMIC_RELAXED, __HIP_MEMORY_SCOPE_AGENT); }
__device__ __forceinline__ unsigned xb_add(unsigned* p, unsigned v) { return __hip_atomic_fetch_add(p, v, __ATOMIC_RELAXED, __HIP_MEMORY_SCOPE_AGENT); }
__device__ __forceinline__ unsigned xb_xcc_id() { return (unsigned)__builtin_amdgcn_s_getreg((3 << 11) | 20) & 0xFu; }
#define XB_SPIN(cond, bar) do { unsigned _sp = 0; while (cond) { __builtin_amdgcn_s_sleep(1); \
    if ((++_sp & 255u) == 0u) { if (xb_ld(&(bar)[XB_TMO])) break; if (_sp > XB_SPIN_CAP) { atomicAdd(&(bar)[XB_TMO], 1u); break; } } } } while (0)
struct XcdBarrier { unsigned* bar; unsigned x; volatile LAS unsigned* st; };
__device__ __forceinline__ XcdBarrier xcd_barrier_post(unsigned* bar, volatile LAS unsigned* st) {
    XcdBarrier b; b.bar = bar; b.x = xb_xcc_id(); b.st = st;
    if (threadIdx.x == 0) (void)xb_add(&bar[XB_XCNT(b.x)], 1u);
    return b;
}
__device__ __forceinline__ void xcd_barrier_complete(unsigned* bar, unsigned x, unsigned& nloc, unsigned& nx) {
    const unsigned G = gridDim.x * gridDim.y * gridDim.z;
    unsigned sum, cnt, mine, sp = 0u;
    for (;;) {
        sum = 0u; cnt = 0u; mine = 0u;
#pragma unroll
        for (unsigned j = 0; j < 16; ++j) { const unsigned c = xb_ld(&bar[XB_XCNT(j)]); sum += c; cnt += (c > 0u) ? 1u : 0u; mine = (j == x) ? c : mine; }
        if (sum == G) break;
        __builtin_amdgcn_s_sleep(1);
        if ((++sp & 255u) == 0u) { if (xb_ld(&bar[XB_TMO])) break; if (sp > XB_SPIN_CAP) { atomicAdd(&bar[XB_TMO], 1u); break; } }
    }
    nloc = mine > 0u ? mine : 1u; nx = cnt > 0u ? cnt : 1u;
}
__device__ __forceinline__ void xcd_barrier(const XcdBarrier& b) {
    asm volatile("s_waitcnt vmcnt(0)" ::: "memory");
    __syncthreads();
    if (threadIdx.x == 0) {
        unsigned* bar = b.bar;
        __builtin_amdgcn_s_waitcnt(0);
        unsigned nloc = b.st[0], nx = b.st[1];
        if (nloc == 0u) { xcd_barrier_complete(bar, b.x, nloc, nx); b.st[0] = nloc; b.st[1] = nx; }
        const unsigned old = xb_add(&bar[XB_XSUB(b.x)], 1u);
        const unsigned gen = old / nloc;
        if (old + 1u == (gen + 1u) * nloc) {
            __builtin_amdgcn_fence(__ATOMIC_RELEASE, "agent");
            asm volatile("s_waitcnt vmcnt(0)" ::: "memory");
            const unsigned og = xb_add(&bar[XB_TOP], 1u);
            const unsigned tg = og / nx;
            if (og + 1u == (tg + 1u) * nx) xb_add(&bar[XB_TOPGEN], 1u);
            else XB_SPIN(xb_ld(&bar[XB_TOPGEN]) == tg, bar);
            __builtin_amdgcn_fence(__ATOMIC_ACQUIRE, "agent");
            xb_add(&bar[XB_XGEN(b.x)], 1u);
            asm volatile("s_waitcnt vmcnt(0)" ::: "memory");
        } else {
            XB_SPIN(xb_ld(&bar[XB_XGEN(b.x)]) == gen, bar);
            __builtin_amdgcn_fence(__ATOMIC_ACQUIRE, "agent");
            asm volatile("s_waitcnt vmcnt(0)" ::: "memory");
        }
    }
    __syncthreads();
}

__device__ __forceinline__ float wave_sum(float v) {
#pragma unroll
    for (int o = 1; o < 64; o <<= 1) v += __shfl_xor(v, o);
    return v;
}
__device__ __forceinline__ void tr_item(const float* W, int ldw, int c0, int k0, bf16* WT, int K, int r0, int nw, LAS float* scr, int lane) {
    const int nn = lane & 31;
    float tv[32];
    const float* src = W + (size_t)(k0 + (lane >> 5)) * ldw + c0 + nn;
#pragma unroll
    for (int i = 0; i < 32; ++i) tv[i] = (nn < nw) ? src[(size_t)(2 * i) * ldw] : 0.f;
#pragma unroll
    for (int i = 0; i < 32; ++i) scr[(2 * i + (lane >> 5)) * 33 + nn] = tv[i];
    LDS_WAIT(); asm volatile("" ::: "memory");
    const int c = lane & 7;
#pragma unroll
    for (int j = 0; j < 4; ++j) { const int n = (lane >> 3) + 8 * j; const LAS float* s = scr + (8 * c) * 33 + n;
        u32x4 o; o.x = pk2(s[0 * 33], s[1 * 33]); o.y = pk2(s[2 * 33], s[3 * 33]); o.z = pk2(s[4 * 33], s[5 * 33]); o.w = pk2(s[6 * 33], s[7 * 33]);
        if (n < nw) *(u32x4*)(WT + (size_t)(r0 + n) * K + k0 + 8 * c) = o; }
    LDS_WAIT(); asm volatile("" ::: "memory");
}

__device__ __forceinline__ f32x2 cmul(f32x2 a, f32x2 b) { return (f32x2){a[0] * b[0] - a[1] * b[1], a[0] * b[1] + a[1] * b[0]}; }
__device__ __forceinline__ f32x2 cfma(f32x2 a, f32x2 b, f32x2 c) {
    const f32x2 bx = __builtin_shufflevector(b, b, 0, 0), by = __builtin_shufflevector(b, b, 1, 1);
    const f32x2 ar = (f32x2){-a[1], a[0]};
    return __builtin_elementwise_fma(bx, a, __builtin_elementwise_fma(by, ar, c));
}
__device__ __forceinline__ f32x2 shfl2(f32x2 v, int src) { return (f32x2){__shfl(v[0], src), __shfl(v[1], src)}; }
__device__ __forceinline__ f32x2 shflup2(f32x2 v, int d) { return (f32x2){__shfl_up(v[0], d), __shfl_up(v[1], d)}; }
__device__ __forceinline__ float bf_round(float x) { return bflo(pk2(x, 0.f)); }
struct S5W { f32x2 lam[4], lam4[4], lam8[4], lamin[4]; bf16x8 bf[8]; };
__device__ __forceinline__ void s5_state_params(const Args& a, int g, int n, f32x2& lam, f32x2& cc) {
    const float dt = expf(a.in[I_S5LDT][g]);
    const float ar = a.in[I_S5AR][g * 64 + n], ai = a.in[I_S5AI][g * 64 + n];
    const float mag = expf(ar * dt);
    const double x = (double)ai * (double)dt;
    const double kq = rint(x * 0.15915494309189535), r = x - kq * 6.283185307179586, r2 = r * r;
    double ts = r, ss = r, tc = 1.0, sc = 1.0;
#pragma unroll
    for (int k = 0; k < 12; ++k) { ts *= -r2 * (1.0 / (double)((2 * k + 2) * (2 * k + 3))); ss += ts; tc *= -r2 * (1.0 / (double)((2 * k + 1) * (2 * k + 2))); sc += tc; }
    const float lr = mag * (float)sc, li = mag * (float)ss;
    const float nr = lr - 1.f, ni = li, den = ar * ar + ai * ai;
    lam = (f32x2){lr, li}; cc = (f32x2){(nr * ar + ni * ai) / den, (ni * ar - nr * ai) / den};
}
__device__ __forceinline__ void s5_setup(const Args& a, int g, int l, S5W& W, const f32x2 lamS, const f32x2 ccS) {
    const int col = l & 15, rg = l >> 4;
#pragma unroll
    for (int j = 0; j < 4; ++j) {
        const int n = 16 * j + col;
        const f32x2 lam = shfl2(lamS, n), cj = shfl2(ccS, n);
        const f32x2 l2 = cmul(lam, lam), l4 = cmul(l2, l2), l8 = cmul(l4, l4);
        W.lam[j] = lam; W.lam4[j] = rg >= 1 ? l4 : (f32x2){0.f, 0.f}; W.lam8[j] = rg >= 2 ? l8 : (f32x2){0.f, 0.f};
        W.lamin[j] = rg == 0 ? (f32x2){1.f, 0.f} : rg == 1 ? l4 : rg == 2 ? l8 : cmul(l8, l4);
        const float* br = a.in[I_S5BR] + (size_t)(g * 64 + n) * 16 + 8 * (rg & 1); const float* bi = a.in[I_S5BI] + (size_t)(g * 64 + n) * 16 + 8 * (rg & 1);
        const f32x4 r0 = *(const f32x4*)br, r1 = *(const f32x4*)(br + 4), i0 = *(const f32x4*)bi, i1 = *(const f32x4*)(bi + 4);
        f32x4 xr0 = r0 * cj[0] - i0 * cj[1], xr1 = r1 * cj[0] - i1 * cj[1], xi0 = i0 * cj[0] + r0 * cj[1], xi1 = i1 * cj[0] + r1 * cj[1];
        if (rg >= 2) {
#pragma unroll
            for (int q = 0; q < 4; ++q) { xr0[q] -= bf_round(xr0[q]); xr1[q] -= bf_round(xr1[q]); xi0[q] -= bf_round(xi0[q]); xi1[q] -= bf_round(xi1[q]); }
        }
        W.bf[j] = __builtin_bit_cast(bf16x8, pack8(xr0, xr1)); W.bf[4 + j] = __builtin_bit_cast(bf16x8, pack8(xi0, xi1));
    }
}
__device__ __forceinline__ u32x4 s5_load_u(const bf16* PROJ, int tok0, int g, int nvalid, int l) {
    const int col = l & 15, rg = l >> 4;
    u32x4 au = (u32x4){0u, 0u, 0u, 0u};
    if (col < nvalid) au = *(const u32x4*)(PROJ + (size_t)(tok0 + col) * NPROJ + g * 16 + 8 * (rg & 1));
    return au;
}
__device__ __forceinline__ void s5_bu_tile(const u32x4 au, const S5W& W, f32x4 (&d)[8]) {
    const bf16x8 av = __builtin_bit_cast(bf16x8, au);
#pragma unroll
    for (int jt = 0; jt < 8; ++jt) d[jt] = __builtin_amdgcn_mfma_f32_16x16x32_bf16(av, W.bf[jt], (f32x4){0.f, 0.f, 0.f, 0.f}, 0, 0, 0);
}
__device__ __forceinline__ void s5_scan_block(const S5W& W, int j, int rg, const f32x4& dre, const f32x4& dim, f32x2 hin, f32x2 (&h)[4]) {
    const f32x2 b0 = (f32x2){dre[0], dim[0]}, b1 = (f32x2){dre[1], dim[1]}, b2 = (f32x2){dre[2], dim[2]}, b3 = (f32x2){dre[3], dim[3]};
    const f32x2 l3 = cfma(W.lam[j], cfma(W.lam[j], cfma(W.lam[j], b0, b1), b2), b3);
    f32x2 P = l3, t;
    t = shflup2(P, 16); P = cfma(W.lam4[j], t, P);
    t = shflup2(P, 32); P = cfma(W.lam8[j], t, P);
    const float m1 = rg >= 1 ? 1.f : 0.f;
    const f32x2 e = shflup2(P, 16) * m1;
    const f32x2 cin = cfma(W.lamin[j], hin, e);
    h[0] = cfma(W.lam[j], cin, b0); h[1] = cfma(W.lam[j], h[0], b1); h[2] = cfma(W.lam[j], h[1], b2); h[3] = cfma(W.lam[j], h[2], b3);
}

struct Ctx { LAS unsigned char* lds; int tid, lane, wave, G, blk; };

constexpr int I_IN = 32 * 288, I_BA = 32, I_GLU = 16 * 32, I_AB = 16 * 64, I_OUT = 32 * 64, I_GU = 32 * 176, I_DN = 88 * 64, I_PL = 4 * 64;
constexpr int CV_EARLY = I_IN + I_BA + I_GLU + 2 * I_AB + I_OUT, CV_ALL = CV_EARLY + I_OUT + 2 * I_GU + I_DN + I_PL;
constexpr int P1_GEMM_WGS = 222;
__device__ __forceinline__ void conv_range(const Args& a, const Ctx& c, int lo, int hi, int gw, int NGW) {
    unsigned char* ws = a.ws;
    LAS float* scr = (LAS float*)(c.lds + c.wave * 16384);
    for (int it = lo + gw; it < hi; it += NGW) {
        int r = it;
        if (r < I_IN) { const int kb = r / 288, nb = r % 288, r0 = 32 * nb, c0 = r0 + (r0 >= 5120 ? 16 : 0); tr_item(a.in[I_WIN], NIN, c0, 64 * kb, (bf16*)(ws + WS_WIN), DM, r0, 32, scr, c.lane); continue; } r -= I_IN;
        if (r < I_BA) { tr_item(a.in[I_WIN], NIN, 5120, 64 * r, (bf16*)(ws + WS_WIN), DM, 9216, 16, scr, c.lane); continue; } r -= I_BA;
        if (r < I_GLU) { const int kb = r / 32, nb = r % 32; tr_item(a.in[I_WGLU], 1024, 32 * nb, 64 * kb, (bf16*)(ws + WS_WGLU), 1024, 32 * nb, 32, scr, c.lane); continue; } r -= I_GLU;
        if (r < I_AB) { const int kb = r / 64, nb = r % 64; tr_item(a.in[I_WA], DM, 32 * nb, 64 * kb, (bf16*)(ws + WS_WA), DM, 32 * nb, 32, scr, c.lane); continue; } r -= I_AB;
        if (r < I_AB) { const int kb = r / 64, nb = r % 64; tr_item(a.in[I_WB], DM, 32 * nb, 64 * kb, (bf16*)(ws + WS_WA) + 1024, DM, 32 * nb, 32, scr, c.lane); continue; } r -= I_AB;
        if (r < I_OUT) { const int kb = r / 64, nb = r % 64; tr_item(a.in[I_WOUT], DM, 32 * nb, 64 * kb, (bf16*)(ws + WS_WOUT), DM, 32 * nb, 32, scr, c.lane); continue; } r -= I_OUT;
        if (r < I_OUT) { const int kb = r / 64, nb = r % 64; tr_item(a.in[I_WPG], DM, 32 * nb, 64 * kb, (bf16*)(ws + WS_WPG), DM, 32 * nb, 32, scr, c.lane); continue; } r -= I_OUT;
        if (r < I_GU) { const int kb = r / 176, nb = r % 176; tr_item(a.in[I_WGATE], FF, 32 * nb, 64 * kb, (bf16*)(ws + WS_WGU), DM, 256 * (nb >> 2) + 32 * (nb & 3), 32, scr, c.lane); continue; } r -= I_GU;
        if (r < I_GU) { const int kb = r / 176, nb = r % 176; tr_item(a.in[I_WUP], FF, 32 * nb, 64 * kb, (bf16*)(ws + WS_WGU), DM, 256 * (nb >> 2) + 32 * (nb & 3) + 128, 32, scr, c.lane); continue; } r -= I_GU;
        if (r < I_DN) { const int kb = r / 64, nb = r % 64; tr_item(a.in[I_WDOWN], DM, 32 * nb, 64 * kb, (bf16*)(ws + WS_WDOWN), FF, 32 * nb, 32, scr, c.lane); continue; } r -= I_DN;
        { const int kb = r / 64, nb = r % 64; tr_item(a.in[I_WPLE], DM, 32 * nb, 64 * kb, (bf16*)(ws + WS_WPLE), PLE, 32 * nb, 32, scr, c.lane); }
    }
}
__device__ __forceinline__ void phase0(const Args& a, const Ctx& c) {
    unsigned char* ws = a.ws;
    const int gw = c.blk * 8 + c.wave, NGW = c.G * 8;
    conv_range(a, c, 0, CV_EARLY, gw, NGW);
    bf16* HB = (bf16*)(ws + WS_HB);
    for (int m = gw; m < TT; m += NGW) {
        const float* xr = (m < TP) ? a.in[I_XP] + (size_t)m * DM : a.in[I_XS] + (size_t)(m - TP) * DM;
        f32x4 v[8]; float s = 0.f;
#pragma unroll
        for (int j = 0; j < 8; ++j) { v[j] = ((const f32x4*)xr)[c.lane + 64 * j]; s += (v[j][0] * v[j][0] + v[j][1] * v[j][1]) + (v[j][2] * v[j][2] + v[j][3] * v[j][3]); }
        const float rs = 1.f / sqrtf(wave_sum(s) * (1.f / DM) + EPS);
#pragma unroll
        for (int j = 0; j < 8; ++j) { const f32x4 gq = ((const f32x4*)a.in[I_GMIX])[c.lane + 64 * j]; const f32x4 o = v[j] * gq * rs;
            u32x2 w; w.x = pk2(o[0], o[1]); w.y = pk2(o[2], o[3]); ((u32x2*)(HB + (size_t)m * DM))[c.lane + 64 * j] = w; }
    }
    bf16* PB = (bf16*)(ws + WS_PB);
    const int gt = c.blk * 512 + c.tid, NGT = c.G * 512;
    for (int i = gt; i < TT * PLE / 4; i += NGT) {
        const int e = i * 4; const f32x4 v = (e < TP * PLE) ? *(const f32x4*)(a.in[I_PP] + e) : *(const f32x4*)(a.in[I_PS] + (e - TP * PLE));
        u32x2 w; w.x = pk2(v[0], v[1]); w.y = pk2(v[2], v[3]); *(u32x2*)(PB + e) = w;
    }
}

constexpr int L_KH = 0, L_QH = 17408, L_VF = 34816, L_LM = 68608, L_GC = 84992, L_BETA = 85248, L_EG = 85504;
__device__ __forceinline__ void dn_precompute(const Args& a, const Ctx& c, int item) {
    const int b = item >> 8, ch = (item >> 3) & 31, h = item & 7;
    const bf16* PROJ = (const bf16*)(a.ws + WS_PROJ);
    const float* BA = (const float*)(a.ws + WS_BA);
    unsigned char* dn = (unsigned char*)a.out + (size_t)item * DN_ITEM;
    const int tok0 = b * SEQ + ch * 64;
    LAS unsigned char* L = c.lds;
    int tid = c.tid; asm volatile("" : "+v"(tid));
    const int l = tid & 63, w = __builtin_amdgcn_readfirstlane(tid >> 6);
    float bl = 0.f, al = 0.f;
    if (w == 0) { bl = BA[(size_t)(tok0 + l) * 16 + h]; al = BA[(size_t)(tok0 + l) * 16 + 8 + h]; }
    {
        float outv[3][8][2];
        unsigned xraw[3][11];
#pragma unroll
        for (int p = 0; p < 3; ++p) {
            const int col = 1024 + p * 1024 + h * 128 + 2 * l;
#pragma unroll
            for (int i = 0; i < 11; ++i) { const int ti = ch * 64 + 8 * w + i - 3;
                xraw[p][i] = 0u; if (ti >= 0) xraw[p][i] = *(const unsigned*)(PROJ + (size_t)(b * SEQ + ti) * NPROJ + col); }
        }
#pragma unroll
        for (int p = 0; p < 3; ++p) {
            f32x2 xr[11], wt[4];
#pragma unroll
            for (int j = 0; j < 4; ++j) wt[j] = *(const f32x2*)(a.in[I_CONVW] + j * CONVC + p * 1024 + h * 128 + 2 * l);
#pragma unroll
            for (int i = 0; i < 11; ++i) xr[i] = (f32x2){bflo(xraw[p][i]), bfhi(xraw[p][i])};
#pragma unroll
            for (int t = 0; t < 8; ++t) { f32x2 s = xr[t] * wt[0] + xr[t + 1] * wt[1] + xr[t + 2] * wt[2] + xr[t + 3] * wt[3];
                outv[p][t][0] = siluf_(s[0]); outv[p][t][1] = siluf_(s[1]); }
        }
#pragma unroll
        for (int t = 0; t < 8; ++t) {
            const float sq = wave_sum(outv[0][t][0] * outv[0][t][0] + outv[0][t][1] * outv[0][t][1]);
            const float sk = wave_sum(outv[1][t][0] * outv[1][t][0] + outv[1][t][1] * outv[1][t][1]);
            const float rq = __builtin_amdgcn_rsqf(sq + EPS) * 0.08838834764831845f, rk = __builtin_amdgcn_rsqf(sk + EPS);
            const int i = 8 * w + t;
            *(LAS unsigned*)(L + L_QH + i * 272 + 4 * l) = pk2(outv[0][t][0] * rq, outv[0][t][1] * rq);
            *(LAS unsigned*)(L + L_KH + i * 272 + 4 * l) = pk2(outv[1][t][0] * rk, outv[1][t][1] * rk);
            *(LAS f32x2*)(L + L_VF + i * 528 + 8 * l) = (f32x2){outv[2][t][0], outv[2][t][1]};
        }
    }
    if (w == 0) {
        const float xx = al + a.in[I_DTB][h];
        const float sp = fmaxf(xx, 0.f) + log1pf(__expf(-fabsf(xx)));
        float g = -__expf(a.in[I_ALOG][h]) * sp;
#pragma unroll
        for (int o = 1; o < 64; o <<= 1) { const float t = __shfl_up(g, o); if (l >= o) g += t; }
        ((LAS float*)(L + L_GC))[l] = g; ((LAS float*)(L + L_BETA))[l] = sigmoidf_(bl); ((LAS float*)(L + L_EG))[l] = __expf(g);
        if (l == 63) ((float*)(a.ws + WS_GL))[item] = __expf(g);
    }
    __syncthreads();
    const LAS float* GC = (const LAS float*)(L + L_GC); const LAS float* BETA = (const LAS float*)(L + L_BETA); const LAS float* EG = (const LAS float*)(L + L_EG);
    {
        const int sel = w >> 2, mt = w & 3, fr = l & 15, fq = l >> 4;
        const LAS unsigned char* Ab = L + (sel ? L_QH : L_KH) + (16 * mt + fr) * 272 + fq * 16;
        bf16x8 af[4];
#pragma unroll
        for (int s = 0; s < 4; ++s) af[s] = *(const LAS bf16x8*)(Ab + s * 64);
#pragma unroll
        for (int nt = 0; nt < 4; ++nt) {
            f32x4 d = (f32x4){0.f, 0.f, 0.f, 0.f};
            const LAS unsigned char* Bb = L + L_KH + (16 * nt + fr) * 272 + fq * 16;
#pragma unroll
            for (int s = 0; s < 4; ++s) d = __builtin_amdgcn_mfma_f32_16x16x32_bf16(af[s], *(const LAS bf16x8*)(Bb + s * 64), d, 0, 0, 0);
            const int j = 16 * nt + fr; const float gj = GC[j];
#pragma unroll
            for (int r = 0; r < 4; ++r) { const int i = 16 * mt + 4 * fq + r; const float dec = __expf(fminf(GC[i] - gj, 0.f));
                if (sel == 0) ((LAS float*)(L + L_LM))[i * 64 + j] = (i > j) ? BETA[i] * d[r] * dec : 0.f;
                else { const float v = (i >= j) ? d[r] * dec : 0.f; ((bf16*)(dn + DN_QK))[i * 64 + permk(j)] = (bf16)(pk2(v, 0.f) & 0xffffu); } }
        }
    }
    __syncthreads();
    if (w < 4) {
        const int col = tid; const bool isu = col < 128; const int cc = col & 127;
        float x[64];
        if (isu) {
            LAS unsigned char* vb = L + L_VF + 4 * cc; asm volatile("" : "+v"(vb));
#pragma unroll
            for (int i = 0; i < 64; ++i) x[i] = *(const LAS float*)(vb + i * 528);
        } else {
            LAS unsigned char* kb = L + L_KH + 2 * cc; asm volatile("" : "+v"(kb));
#pragma unroll
            for (int i = 0; i < 64; ++i) x[i] = bf2f(*(const LAS bf16*)(kb + i * 272));
        }
        {
            LAS unsigned char* bb_ = L + L_BETA; asm volatile("" : "+v"(bb_));
#pragma unroll
            for (int i4 = 0; i4 < 16; ++i4) { const f32x4 bv = *(const LAS f32x4*)(bb_ + 16 * i4); f32x4 ev = *(const LAS f32x4*)(bb_ + 256 + 16 * i4); if (isu) ev = (f32x4){1.f, 1.f, 1.f, 1.f};
#pragma unroll
                for (int jj = 0; jj < 4; ++jj) x[4 * i4 + jj] *= bv[jj] * ev[jj]; }
        }
        asm volatile("" ::: "memory");
        LAS unsigned char* lmb = L + L_LM; asm volatile("" : "+v"(lmb));
        f32x4 lq[2][16];
        lq[1][0] = *(const LAS f32x4*)(lmb + 256);
#pragma unroll
        for (int i = 1; i < 64; ++i) {
            if (i + 1 < 64) {
#pragma unroll
                for (int j4 = 0; j4 < (i + 4) / 4; ++j4) lq[(i + 1) & 1][j4] = *(const LAS f32x4*)(lmb + (i + 1) * 256 + j4 * 16);
            }
            asm volatile("" ::: "memory");
            float r0 = x[i], r1 = 0.f, r2 = 0.f, r3 = 0.f;
#pragma unroll
            for (int j4 = 0; j4 < (i + 3) / 4; ++j4) { const f32x4 lv = lq[i & 1][j4];
                if (4 * j4 + 0 < i) r0 -= lv[0] * x[4 * j4 + 0];
                if (4 * j4 + 1 < i) r1 -= lv[1] * x[4 * j4 + 1];
                if (4 * j4 + 2 < i) r2 -= lv[2] * x[4 * j4 + 2];
                if (4 * j4 + 3 < i) r3 -= lv[3] * x[4 * j4 + 3]; }
            x[i] = (r0 + r1) + (r2 + r3);
        }
        if (isu) {
            const int es = cc >> 4, n = cc & 15;
#pragma unroll
            for (int q = 0; q < 16; ++q) { const int mt = q >> 2, rg = q & 3;
                u32x2 wv; wv.x = pk2(x[4 * q], x[4 * q + 1]); wv.y = pk2(x[4 * q + 2], x[4 * q + 3]);
                *(u32x2*)(dn + DN_U + (size_t)(((es * 4 + mt) * 64 + rg * 16 + n) * 4) * 2) = wv; }
        } else {
            const int pd = permk(cc);
#pragma unroll
            for (int i = 0; i < 64; ++i) ((bf16*)(dn + DN_W))[i * 128 + pd] = (bf16)(pk2(-x[i], 0.f) & 0xffffu);
        }
    } else {
        const int t2 = tid - 256;
        { const int d2 = t2 & 63, i0 = t2 >> 6; const int pd = permk(2 * d2);
#pragma unroll
          for (int k = 0; k < 16; ++k) { const int i = i0 + 4 * k; const unsigned qv = *(const LAS unsigned*)(L + L_QH + i * 272 + 4 * d2); const float e = EG[i];
              *(unsigned*)(dn + DN_QG + (size_t)(i * 128 + pd) * 2) = pk2(bflo(qv) * e, bfhi(qv) * e); } }
        { const int d = t2 & 127, hf = t2 >> 7; const float gl = GC[63];
#pragma unroll
          for (int q = 0; q < 8; ++q) { const int jq = hf * 8 + q;
              const int j0 = 32 * (jq >> 3) + 16 * (jq & 1) + 4 * ((jq >> 1) & 3);
              float kv[4];
#pragma unroll
              for (int r = 0; r < 4; ++r) kv[r] = bf2f(*(const LAS bf16*)(L + L_KH + (j0 + r) * 272 + 2 * d)) * __expf(gl - GC[j0 + r]);
              u32x2 wv; wv.x = pk2(kv[0], kv[1]); wv.y = pk2(kv[2], kv[3]);
              *(u32x2*)(dn + DN_KGT + (size_t)(d * 64 + 4 * jq) * 2) = wv; } }
    }
    __syncthreads();
}

__device__ __forceinline__ void s5_pass1(const Args& a, const Ctx& c, int g, int first, int stride) {
    const bf16* PROJ = (const bf16*)(a.ws + WS_PROJ);
    int l = c.lane; asm volatile("" : "+v"(l));
    const int col = l & 15, rg = l >> 4;
    f32x2 lamS, ccS; s5_state_params(a, g, l, lamS, ccS);
    S5W W; s5_setup(a, g, l, W, lamS, ccS);
    for (int k = first; k < NBP * 31; k += stride) {
        const int b = k / 31, ch = k % 31;
        const int tok0 = b * SEQ + ch * 64;
        u32x4 au[4];
#pragma unroll
        for (int st = 0; st < 4; ++st) au[st] = s5_load_u(PROJ, tok0 + 16 * st, g, 16, l);
        f32x2 hin[4];
#pragma unroll
        for (int j = 0; j < 4; ++j) hin[j] = (f32x2){0.f, 0.f};
#pragma unroll
        for (int st = 0; st < 4; ++st) {
            f32x4 d[8]; s5_bu_tile(au[st], W, d);
#pragma unroll
            for (int j = 0; j < 4; ++j) { f32x2 h[4]; s5_scan_block(W, j, rg, d[j], d[4 + j], hin[j], h); hin[j] = shfl2(h[3], 48 + col); }
        }
        const f32x2 ho = rg == 0 ? hin[0] : rg == 1 ? hin[1] : rg == 2 ? hin[2] : hin[3];
        *(f32x2*)(a.ws + WS_E + ((size_t)((b * NCH + ch) * NG + g) * 64 + l) * 8) = ho;
    }
}

__device__ __forceinline__ void s5_pass2(const Args& a, const Ctx& c, int g, int first, int stride, int vend) {
    const bf16* PROJ = (const bf16*)(a.ws + WS_PROJ);
    bf16* YG = (bf16*)(a.ws + WS_YG);
    LAS unsigned char* hb = c.lds + c.wave * 8192;
    int l = c.lane; asm volatile("" : "+v"(l));
    const int fr = l & 15, fq = l >> 4, col = fr, rg = fq;
    f32x2 lamS, ccS; s5_state_params(a, g, l, lamS, ccS);
    f32x2 pw64 = lamS;
#pragma unroll
    for (int q = 0; q < 6; ++q) pw64 = cmul(pw64, pw64);
    S5W W; s5_setup(a, g, l, W, lamS, ccS);
    bf16x8 cf[4];
#pragma unroll
    for (int s = 0; s < 4; ++s) { const int n0 = 16 * s + 4 * fq;
        const f32x4 vr = *(const f32x4*)(a.in[I_S5CR] + (size_t)(g * 16 + fr) * 64 + n0), vi = *(const f32x4*)(a.in[I_S5CI] + (size_t)(g * 16 + fr) * 64 + n0);
        cf[s] = __builtin_bit_cast(bf16x8, pack8((f32x4){vr[0], -vi[0], vr[1], -vi[1]}, (f32x4){vr[2], -vi[2], vr[3], -vi[3]})); }
    const float dsk = a.in[I_S5D][g * 16 + fr];
    for (int v = first; v < vend; v += stride) {
        const int k = (v & 1) ? 128 + (v >> 1) : (v >> 1);
        const bool prompt = k < 128;
        int tok0, nsub, nvalid, b = 0, ch = 0, sq = 0;
        if (prompt) { ch = k & 31; b = k >> 5; tok0 = b * SEQ + ch * 64; nsub = 4; nvalid = 16; }
        else { sq = k - 128; tok0 = TP + sq * LSM; nsub = 1; nvalid = LSM; }
        u32x4 au[4];
#pragma unroll
        for (int st = 0; st < 4; ++st) { au[st] = (u32x4){0u, 0u, 0u, 0u}; if (st < nsub) au[st] = s5_load_u(PROJ, tok0 + 16 * st, g, nvalid, l); }
        f32x2 hs = (f32x2){0.f, 0.f};
        if (prompt) {
            const f32x2* E = (const f32x2*)(a.ws + WS_E) + ((size_t)(b * NCH) * NG + g) * 64 + l;
            for (int j0 = 0; j0 < ch; j0 += 16) {
                f32x2 ev[16];
#pragma unroll
                for (int j = 0; j < 16; ++j) { ev[j] = (f32x2){0.f, 0.f}; if (j0 + j < ch) ev[j] = E[(size_t)(j0 + j) * NG * 64]; }
#pragma unroll
                for (int j = 0; j < 16; ++j) if (j0 + j < ch) hs = cfma(pw64, hs, ev[j]);
            }
        } else {
            hs = (f32x2){a.in[I_S5RE][(size_t)(sq * NG + g) * 64 + l], a.in[I_S5IM][(size_t)(sq * NG + g) * 64 + l]};
        }
        f32x2 hin[4];
#pragma unroll
        for (int j = 0; j < 4; ++j) hin[j] = shfl2(hs, 16 * j + col);
        const int endsrc = ((nvalid - 1) >> 2) * 16 + col;
#pragma unroll
        for (int st = 0; st < 4; ++st) {
            if (st < nsub) {
            f32x4 d[8]; s5_bu_tile(au[st], W, d);
            if (fq < 2) *(LAS u32x4*)(hb + 4608 + fr * 32 + fq * 16) = au[st];
#pragma unroll
            for (int j = 0; j < 4; ++j) { f32x2 h[4]; s5_scan_block(W, j, rg, d[j], d[4 + j], hin[j], h); hin[j] = shfl2(h[3], endsrc);
#pragma unroll
                for (int i = 0; i < 4; ++i) *(LAS unsigned*)(hb + (4 * rg + i) * 272 + 4 * (16 * j + col)) = pk2(h[i][0], h[i][1]); }
            LDS_WAIT(); asm volatile("" ::: "memory");
            f32x4 y = (f32x4){0.f, 0.f, 0.f, 0.f};
#pragma unroll
            for (int s = 0; s < 4; ++s) y = __builtin_amdgcn_mfma_f32_16x16x32_bf16(*(const LAS bf16x8*)(hb + fr * 272 + s * 64 + fq * 16), cf[s], y, 0, 0, 0);
#pragma unroll
            for (int r = 0; r < 4; ++r) { const int t = 4 * fq + r;
                if (t < nvalid) { const float v = y[r] + dsk * bf2f(*(const LAS bf16*)(hb + 4608 + t * 32 + fr * 2)); YG[(size_t)(tok0 + 16 * st + t) * 1024 + g * 16 + fr] = (bf16)(pk2(gelu_tanh(v), 0.f) & 0xffffu); } }
            LDS_WAIT(); asm volatile("" ::: "memory");
            }
        }
        const f32x2 ho = rg == 0 ? hin[0] : rg == 1 ? hin[1] : rg == 2 ? hin[2] : hin[3];
        if (prompt) { if (ch == 31) { a.out[O_S5RP + (size_t)(b * NG + g) * 64 + l] = ho[0]; a.out[O_S5IP + (size_t)(b * NG + g) * 64 + l] = ho[1]; } }
        else { a.out[O_S5RS + (size_t)(sq * NG + g) * 64 + l] = ho[0]; a.out[O_S5IS + (size_t)(sq * NG + g) * 64 + l] = ho[1]; }
    }
}

constexpr int Q_W = 0, Q_QG = 17408, Q_KGT = 34816, Q_QK = 53248;
__device__ __forceinline__ void dn_sequential(const Args& a, const Ctx& c, int bh) {
    int tid = c.tid; asm volatile("" : "+v"(tid));
    const int b = bh >> 3, h = bh & 7, es = __builtin_amdgcn_readfirstlane(tid >> 6), l = tid & 63, fr = l & 15, fq = l >> 4;
    LAS unsigned char* L = c.lds;
    float* O = (float*)(a.ws + WS_O);
    const float* GL = (const float*)(a.ws + WS_GL);
    f32x4 S[8];
#pragma unroll
    for (int i = 0; i < 8; ++i) S[i] = (f32x4){0.f, 0.f, 0.f, 0.f};
    constexpr int QBUF = 62464;
    u32x4 pw[2], pq[2], pk_[2], pqk; u32x2 uu[4]; float gl;
#define DNQ_LOAD(chn) do { const int item_ = (b * NCH + (chn)) * NH + h; const unsigned char* dn_ = (const unsigned char*)a.out + (size_t)item_ * DN_ITEM; \
        _Pragma("unroll") for (int q = 0; q < 2; ++q) { const int p = tid + 512 * q; pw[q] = *(const u32x4*)(dn_ + DN_W + (size_t)p * 16); pq[q] = *(const u32x4*)(dn_ + DN_QG + (size_t)p * 16); pk_[q] = *(const u32x4*)(dn_ + DN_KGT + (size_t)p * 16); } \
        pqk = *(const u32x4*)(dn_ + DN_QK + (size_t)tid * 16); \
        _Pragma("unroll") for (int mt = 0; mt < 4; ++mt) uu[mt] = *(const u32x2*)(dn_ + DN_U + (size_t)(((es * 4 + mt) * 64 + l) * 4) * 2); \
        gl = GL[item_]; } while (0)
#define DNQ_STORE(Lb) do { \
        _Pragma("unroll") for (int q = 0; q < 2; ++q) { const int p = tid + 512 * q; *(LAS u32x4*)((Lb) + Q_W + (p >> 4) * 272 + (p & 15) * 16) = pw[q]; *(LAS u32x4*)((Lb) + Q_QG + (p >> 4) * 272 + (p & 15) * 16) = pq[q]; \
            *(LAS u32x4*)((Lb) + Q_KGT + (p >> 3) * 144 + (p & 7) * 16) = pk_[q]; } \
        *(LAS u32x4*)((Lb) + Q_QK + (tid >> 3) * 144 + (tid & 7) * 16) = pqk; } while (0)
    DNQ_LOAD(0);
    DNQ_STORE(L);
    __syncthreads();
    for (int ch = 0; ch < NCH; ++ch) {
        LAS unsigned char* Lc = L + (ch & 1) * QBUF;
        const u32x2 uc0 = uu[0], uc1 = uu[1], uc2 = uu[2], uc3 = uu[3]; const float glc = gl;
        if (ch + 1 < NCH) DNQ_LOAD(ch + 1);
        bf16x8 Sb[4];
#pragma unroll
        for (int s = 0; s < 4; ++s) Sb[s] = __builtin_bit_cast(bf16x8, pack8(S[2 * s], S[2 * s + 1]));
        f32x4 vn[4];
#pragma unroll
        for (int mt = 0; mt < 4; ++mt) {
            const u32x2 ucm = mt == 0 ? uc0 : mt == 1 ? uc1 : mt == 2 ? uc2 : uc3;
            f32x4 acc = (f32x4){bflo(ucm.x), bfhi(ucm.x), bflo(ucm.y), bfhi(ucm.y)};
#pragma unroll
            for (int s = 0; s < 4; ++s) acc = __builtin_amdgcn_mfma_f32_16x16x32_bf16(*(const LAS bf16x8*)(Lc + Q_W + (16 * mt + fr) * 272 + s * 64 + fq * 16), Sb[s], acc, 0, 0, 0);
            vn[mt] = acc;
        }
        bf16x8 vb[2];
        vb[0] = __builtin_bit_cast(bf16x8, pack8(vn[0], vn[1])); vb[1] = __builtin_bit_cast(bf16x8, pack8(vn[2], vn[3]));
#pragma unroll
        for (int mt = 0; mt < 4; ++mt) {
            f32x4 acc = (f32x4){0.f, 0.f, 0.f, 0.f};
#pragma unroll
            for (int s = 0; s < 4; ++s) acc = __builtin_amdgcn_mfma_f32_16x16x32_bf16(*(const LAS bf16x8*)(Lc + Q_QG + (16 * mt + fr) * 272 + s * 64 + fq * 16), Sb[s], acc, 0, 0, 0);
#pragma unroll
            for (int s = 0; s < 2; ++s) acc = __builtin_amdgcn_mfma_f32_16x16x32_bf16(*(const LAS bf16x8*)(Lc + Q_QK + (16 * mt + fr) * 144 + s * 64 + fq * 16), vb[s], acc, 0, 0, 0);
            const int tok = b * SEQ + ch * 64 + 16 * mt + 4 * fq;
#pragma unroll
            for (int r = 0; r < 4; ++r) O[(size_t)(tok + r) * 1024 + h * 128 + es * 16 + fr] = acc[r];
        }
#pragma unroll
        for (int dt = 0; dt < 8; ++dt) {
            f32x4 acc = S[dt] * glc;
#pragma unroll
            for (int s = 0; s < 2; ++s) acc = __builtin_amdgcn_mfma_f32_16x16x32_bf16(*(const LAS bf16x8*)(Lc + Q_KGT + (16 * dt + fr) * 144 + s * 64 + fq * 16), vb[s], acc, 0, 0, 0);
            S[dt] = acc;
        }
        if (ch + 1 < NCH) DNQ_STORE(L + ((ch + 1) & 1) * QBUF);
        __syncthreads();
    }
#undef DNQ_LOAD
#undef DNQ_STORE
    float* SO = a.out + O_DELTAP + (size_t)(b * NH + h) * HD * HD;
#pragma unroll
    for (int dt = 0; dt < 8; ++dt)
#pragma unroll
        for (int r = 0; r < 4; ++r) SO[(size_t)(16 * dt + 4 * fq + r) * HD + es * 16 + fr] = S[dt][r];
}

__device__ __forceinline__ void dn_sample(const Args& a, const Ctx& c, int item, bool valid) {
    int tid = c.tid; asm volatile("" : "+v"(tid));
    const int wave = __builtin_amdgcn_readfirstlane(tid >> 6), lane = tid & 63;
    const int il = wave >> 1, e = tid & 127, wv = wave & 1;
    const int sq = item >> 3, h = item & 7;
    const bf16* PROJ = (const bf16*)(a.ws + WS_PROJ);
    const float* BA = (const float*)(a.ws + WS_BA);
    LAS float* QS = (LAS float*)(c.lds + il * 8192);
    LAS float* KS = (LAS float*)(c.lds + il * 8192 + 4096);
    LAS float* RED = (LAS float*)(c.lds + 32768 + il * 256);
    float qv[8], kv[8], vv[8];
    float S[128];
    if (valid) {
#pragma unroll
        for (int p = 0; p < 3; ++p) {
            const int cch = p * 1024 + h * 128 + e;
            float wt[4];
#pragma unroll
            for (int j = 0; j < 4; ++j) wt[j] = a.in[I_CONVW][j * CONVC + cch];
            float xr[11];
#pragma unroll
            for (int i = 0; i < 3; ++i) xr[i] = a.in[I_SCONV][(size_t)(sq * 3 + i) * CONVC + cch];
#pragma unroll
            for (int i = 0; i < 8; ++i) xr[3 + i] = bf2f(PROJ[(size_t)(TP + sq * LSM + i) * NPROJ + 1024 + cch]);
#pragma unroll
            for (int t = 0; t < 8; ++t) { const float s = siluf_(xr[t] * wt[0] + xr[t + 1] * wt[1] + xr[t + 2] * wt[2] + xr[t + 3] * wt[3]);
                if (p == 0) qv[t] = s; else if (p == 1) kv[t] = s; else vv[t] = s; }
        }
#pragma unroll
        for (int t = 0; t < 8; ++t) { const float s1 = wave_sum(qv[t] * qv[t]), s2 = wave_sum(kv[t] * kv[t]); if (lane == 0) { RED[wv * 16 + t] = s1; RED[wv * 16 + 8 + t] = s2; } }
    }
    __syncthreads();
    if (valid) {
#pragma unroll
        for (int t = 0; t < 8; ++t) { const float sq_ = RED[t] + RED[16 + t], sk_ = RED[8 + t] + RED[24 + t];
            QS[t * 128 + e] = qv[t] * __builtin_amdgcn_rsqf(sq_ + EPS) * 0.08838834764831845f; KS[t * 128 + e] = kv[t] * __builtin_amdgcn_rsqf(sk_ + EPS); }
    }
    __syncthreads();
    if (valid) {
        { const float* S0 = a.in[I_SDELTA] + (size_t)item * HD * HD + e;
#pragma unroll
          for (int d = 0; d < 128; ++d) S[d] = S0[(size_t)d * HD]; }
        float* O = (float*)(a.ws + WS_O);
        const float alog = __expf(a.in[I_ALOG][h]), dtb = a.in[I_DTB][h];
        for (int t = 0; t < 8; ++t) {
            const int tok = TP + sq * LSM + t;
            const float beta = sigmoidf_(BA[(size_t)tok * 16 + h]); const float xx = BA[(size_t)tok * 16 + 8 + h] + dtb;
            const float aa = __expf(-alog * (fmaxf(xx, 0.f) + log1pf(__expf(-fabsf(xx)))));
            const LAS f32x4* kq = (const LAS f32x4*)(KS + t * 128); const LAS f32x4* qq = (const LAS f32x4*)(QS + t * 128);
            float ks0 = 0.f, ks1 = 0.f, ks2 = 0.f, ks3 = 0.f;
#pragma unroll
            for (int d8 = 0; d8 < 4; ++d8) {
#pragma unroll
                for (int dd = 0; dd < 8; ++dd) { const int d4 = 8 * d8 + dd; const f32x4 k4 = kq[d4]; ks0 += S[4 * d4] * k4[0]; ks1 += S[4 * d4 + 1] * k4[1]; ks2 += S[4 * d4 + 2] * k4[2]; ks3 += S[4 * d4 + 3] * k4[3]; }
                asm volatile("" ::: "memory"); }
            const float vnew = beta * (vv[t] - aa * ((ks0 + ks1) + (ks2 + ks3)));
            float o0 = 0.f, o1 = 0.f, o2 = 0.f, o3 = 0.f;
#pragma unroll
            for (int d8 = 0; d8 < 8; ++d8) {
#pragma unroll
                for (int dd = 0; dd < 4; ++dd) { const int d4 = 4 * d8 + dd; const f32x4 k4 = kq[d4], q4 = qq[d4];
                    float sn;
                    sn = aa * S[4 * d4 + 0] + k4[0] * vnew; S[4 * d4 + 0] = sn; o0 += sn * q4[0];
                    sn = aa * S[4 * d4 + 1] + k4[1] * vnew; S[4 * d4 + 1] = sn; o1 += sn * q4[1];
                    sn = aa * S[4 * d4 + 2] + k4[2] * vnew; S[4 * d4 + 2] = sn; o2 += sn * q4[2];
                    sn = aa * S[4 * d4 + 3] + k4[3] * vnew; S[4 * d4 + 3] = sn; o3 += sn * q4[3]; }
                asm volatile("" ::: "memory"); }
            const float o = (o0 + o1) + (o2 + o3);
            O[(size_t)tok * 1024 + h * 128 + e] = o;
        }
        float* SO = a.out + O_DELTAS + (size_t)item * HD * HD + e;
#pragma unroll
        for (int d = 0; d < 128; ++d) SO[(size_t)d * HD] = S[d];
    }
    __syncthreads();
}

__device__ __forceinline__ void reduce_sample_rows(const Ctx& c, const float* base, const float* slab, float* XO, bf16* XG, const float* gw, float* ssq) {
    for (int r = c.blk * 8 + c.wave; r < TS; r += c.G * 8) {
        float s = 0.f;
#pragma unroll 2
        for (int j = 0; j < 8; ++j) { const int col = 4 * (c.lane + 64 * j);
            f32x4 v = *(const f32x4*)(base + (size_t)r * DM + col);
#pragma unroll
            for (int kc = 0; kc < 8; ++kc) v += *(const f32x4*)(slab + ((size_t)kc * TS + r) * DM + col);
            *(f32x4*)(XO + (size_t)r * DM + col) = v;
            const f32x4 gq = *(const f32x4*)(gw + col); const f32x4 o = v * gq;
            u32x2 w; w.x = pk2(o[0], o[1]); w.y = pk2(o[2], o[3]); *(u32x2*)(XG + (size_t)r * DM + col) = w;
            s += (v[0] * v[0] + v[1] * v[1]) + (v[2] * v[2] + v[3] * v[3]); }
        s = wave_sum(s); if (c.lane == 0) ssq[r] = s;
    }
}

__global__ void __launch_bounds__(512, 2) fwd_megakernel(Args args) {
    extern __shared__ __attribute__((aligned(16))) unsigned char lds_raw[];
    Ctx c; c.lds = (LAS unsigned char*)lds_raw; c.tid = threadIdx.x; c.lane = c.tid & 63; c.wave = __builtin_amdgcn_readfirstlane(c.tid >> 6); c.G = gridDim.x; c.blk = blockIdx.x;
    volatile LAS unsigned* MISC = (volatile LAS unsigned*)(c.lds + MISC_OFF);
    unsigned char* ws = args.ws;
    unsigned* ctl = (unsigned*)(ws + WS_CTL);
    for (int u = c.tid; u < (LDS_BYTES - RING_BYTES) / 4; u += 512) ((LAS unsigned*)(c.lds + RING_BYTES))[u] = 0u;
    __syncthreads();
    XcdBarrier bar; bar.bar = ctl + CW_BAR; bar.x = 0; bar.st = nullptr;
    if (MK_N_LAUNCHES == 1) bar = xcd_barrier_post(ctl + CW_BAR, MISC + 8);
    const int lo = args.ph_lo, hi = args.ph_hi;
#ifndef PH_MASK
#define PH_MASK 0x1fff
#endif
#define IN(k) (((PH_MASK >> (k)) & 1) && lo <= (k) && (k) < hi)
#ifndef REP_MASK
#define REP_MASK 0
#endif
#define PHASE(k) for (int rep_ = 0; IN(k) && rep_ <= ((REP_MASK >> (k)) & 1); ++rep_)
#define REPSYNC() do { if (rep_) xcd_barrier(bar); } while (0)
#define SEAM(k) do { if (IN(k) && IN((k) + 1)) xcd_barrier(bar); } while (0)
    bf16* PROJ = (bf16*)(ws + WS_PROJ);
    float* ssq1 = (float*)(ctl + CW_SSQ1); float* ssq2 = (float*)(ctl + CW_SSQ2); float* ssq3 = (float*)(ctl + CW_SSQ3);
    float* Y = args.out + O_Y;

    PHASE(0) { REPSYNC(); phase0(args, c); } SEAM(0);
    PHASE(1) { REPSYNC();
        if (c.blk < P1_GEMM_WGS) {
            pg8::Gemm g{(const bf16*)(ws + WS_HB), (const bf16*)(ws + WS_WIN), TT, NINP, DM}; pg8::StaticOrder S; S.init(TT, NINP, P1_GEMM_WGS, c.blk);
            EpiProj E{PROJ, (float*)(ws + WS_BA)};
            pg8::gemm_phase<EpiProj, pg8::StaticOrder>(c.lds, g, S, E);
        } else conv_range(args, c, CV_EARLY, CV_ALL, (c.blk - P1_GEMM_WGS) * 8 + c.wave, (c.G - P1_GEMM_WGS) * 8);
    } SEAM(1);
    PHASE(2) { REPSYNC();
#ifndef REPX
#define REPX 0
#endif
        for (int rx = 0; rx <= ((REPX >> 0) & 1); ++rx)
        for (int it = c.blk; it < NBP * NCH * NH; it += c.G) dn_precompute(args, c, it);
        __syncthreads();
        for (int rx = 0; rx <= ((REPX >> 1) & 1); ++rx)
        { const int wi = c.blk * 8 + c.wave; s5_pass1(args, c, wi & 63, wi >> 6, (c.G * 8) >> 6); }
        for (int i = c.blk * 512 + c.tid; i < (NBP + NSB) * 3 * CONVC; i += c.G * 512) {
            const int cc = i % CONVC, rr = (i / CONVC) % 3, sq = i / (3 * CONVC);
            if (sq < NBP) args.out[O_CONVP + (size_t)(sq * 3 + rr) * CONVC + cc] = bf2f(PROJ[(size_t)(sq * SEQ + SEQ - 3 + rr) * NPROJ + 1024 + cc]);
            else { const int s2 = sq - NBP; args.out[O_CONVS + (size_t)(s2 * 3 + rr) * CONVC + cc] = bf2f(PROJ[(size_t)(TP + s2 * LSM + LSM - 3 + rr) * NPROJ + 1024 + cc]); }
        }
    } SEAM(2);
    PHASE(3) { REPSYNC();
        if (c.blk < 32) { for (int rx = 0; rx <= ((REPX >> 2) & 1); ++rx) dn_sequential(args, c, c.blk); }
        else {
            const int nb = c.G - 32, rb = c.blk - 32;
            for (int rx = 0; rx <= ((REPX >> 3) & 1); ++rx) {
                { const int it = rb * 4 + (c.wave >> 1); dn_sample(args, c, it, true); }
                if (rb < 32) { const int it = nb * 4 + rb * 4 + (c.wave >> 1); dn_sample(args, c, it, it < NSB * NH); }
            }
            __syncthreads();
            for (int rx = 0; rx <= ((REPX >> 4) & 1); ++rx)
            { const int wi = rb * 8 + c.wave, slot = wi >> 6;
              if (slot < 4) s5_pass2(args, c, wi & 63, slot, 4, 8); else s5_pass2(args, c, wi & 63, 8 + slot - 4, 24, 256); }
        }
    } SEAM(3);
    PHASE(4) { REPSYNC();
        if (c.blk < 144) {
            pg8::Gemm g{(const bf16*)(ws + WS_YG), (const bf16*)(ws + WS_WGLU), TT, 1024, 1024}; pg8::StaticOrder S; S.init(TT, 1024, 144, c.blk);
            EpiGlu E{(const bf16*)(ws + WS_YG), (bf16*)(ws + WS_YCAT), args.in[I_BGLU]};
            pg8::gemm_phase<EpiGlu, pg8::StaticOrder>(c.lds, g, S, E);
        } else {
            const float* O = (const float*)(ws + WS_O); bf16* YDN = (bf16*)(ws + WS_YCAT) + 1024;
            const f32x2 ow = *(const f32x2*)(args.in[I_ONORM] + 2 * c.lane);
            for (int tok = (c.blk - 144) * 8 + c.wave; tok < TT; tok += (c.G - 144) * 8) {
                const float* orow = O + (size_t)tok * 1024 + 2 * c.lane; const bf16* zrow = PROJ + (size_t)tok * NPROJ + 4096 + 2 * c.lane; bf16* yrow = YDN + (size_t)tok * DM + 2 * c.lane;
                f32x2 o[8]; unsigned zz[8];
#pragma unroll
                for (int h = 0; h < 8; ++h) { o[h] = *(const f32x2*)(orow + h * 128); zz[h] = *(const unsigned*)(zrow + h * 128); }
#pragma unroll
                for (int h = 0; h < 8; ++h) {
                    const float rs = __builtin_amdgcn_rsqf(wave_sum(o[h][0] * o[h][0] + o[h][1] * o[h][1]) * (1.f / HD) + EPS);
                    *(unsigned*)(yrow + h * 128) = pk2(o[h][0] * rs * ow[0] * siluf_(bflo(zz[h])), o[h][1] * rs * ow[1] * siluf_(bfhi(zz[h])));
                }
            }
        }
    } SEAM(4);
    PHASE(5) { REPSYNC();
        pg8::Gemm g{(const bf16*)(ws + WS_YCAT), (const bf16*)(ws + WS_WA), TT, DM, DM, 0}; pg8::StaticOrder S; S.init(TT, DM, c.G, c.blk);
        EpiMix E{PROJ, (bf16*)(ws + WS_MIX)}; pg8::gemm_phase<EpiMix, pg8::StaticOrder>(c.lds, g, S, E);
    } SEAM(5);
    PHASE(6) { REPSYNC();
        { pg8::Gemm g{(const bf16*)(ws + WS_MIX), (const bf16*)(ws + WS_WOUT), TP, DM, DM, 0}; pg8::StaticOrder S; S.init(TP, DM, c.G, c.blk);
          EpiResid E{args.in[I_XP], args.in[I_XS], (float*)(ws + WS_X1), (bf16*)(ws + WS_X1G), args.in[I_GFFN], ssq1};
          pg8::gemm_phase<EpiResid, pg8::StaticOrder>(c.lds, g, S, E); }
        { const int kc = c.blk & 7;
          pg8::Gemm g{(const bf16*)(ws + WS_MIX) + kc * 256, (const bf16*)(ws + WS_WOUT) + kc * 256, TT, DM, 256, DM}; TailOrder S{c.blk};
          EpiSlab E{Y + (size_t)kc * TS * DM};
          pg8::gemm_phase<EpiSlab, TailOrder>(c.lds, g, S, E); }
    } SEAM(6);
    PHASE(7) { REPSYNC();
        reduce_sample_rows(c, args.in[I_XS], Y, (float*)(ws + WS_X1) + (size_t)TP * DM, (bf16*)(ws + WS_X1G) + (size_t)TP * DM, args.in[I_GFFN], ssq1 + TP);
    } SEAM(7);
    PHASE(8) { REPSYNC();
        pg8::Gemm g{(const bf16*)(ws + WS_X1G), (const bf16*)(ws + WS_WGU), TT, 2 * FF, DM}; pg8::StaticOrder S; S.init(TT, 2 * FF, c.G, c.blk);
        EpiGU E{ssq1, (bf16*)(ws + WS_ACT)};
        pg8::gemm_phase<EpiGU, pg8::StaticOrder>(c.lds, g, S, E);
    } SEAM(8);
    PHASE(9) { REPSYNC();
        const float* x1 = (const float*)(ws + WS_X1);
        { pg8::Gemm g{(const bf16*)(ws + WS_ACT), (const bf16*)(ws + WS_WDOWN), TP, DM, FF, 0}; pg8::StaticOrder S; S.init(TP, DM, c.G, c.blk);
          EpiResid E{x1, x1 + (size_t)TP * DM, Y, (bf16*)(ws + WS_X2G), args.in[I_GPLE], ssq2};
          pg8::gemm_phase<EpiResid, pg8::StaticOrder>(c.lds, g, S, E); }
        { const int kc = c.blk & 7, kt0 = (kc >> 1) * 22 + (kc & 1) * 12, nkt = (kc & 1) ? 10 : 12;
          pg8::Gemm g{(const bf16*)(ws + WS_ACT) + kt0 * 64, (const bf16*)(ws + WS_WDOWN) + kt0 * 64, TT, DM, nkt * 64, FF}; TailOrder S{c.blk};
          EpiSlab E{(float*)(ws + WS_SLAB) + (size_t)kc * TS * DM};
          pg8::gemm_phase<EpiSlab, TailOrder>(c.lds, g, S, E); }
    } SEAM(9);
    PHASE(10) { REPSYNC();
        reduce_sample_rows(c, (const float*)(ws + WS_X1) + (size_t)TP * DM, (const float*)(ws + WS_SLAB), Y + (size_t)TP * DM, (bf16*)(ws + WS_X2G) + (size_t)TP * DM, args.in[I_GPLE], ssq2 + TP);
        { pg8::Gemm g{(const bf16*)(ws + WS_PB), (const bf16*)(ws + WS_WPLE), TT, DM, PLE, 0}; pg8::StaticOrder S; S.init(TT, DM, c.G, c.blk);
          EpiF32 E{(float*)(ws + WS_TPLE)}; pg8::gemm_phase<EpiF32, pg8::StaticOrder>(c.lds, g, S, E); }
    } SEAM(10);
    PHASE(11) { REPSYNC();
        { pg8::Gemm g{(const bf16*)(ws + WS_X2G), (const bf16*)(ws + WS_WPG), TP, DM, DM, 0}; pg8::StaticOrder S; S.init(TP, DM, c.G, c.blk);
          EpiPleB E{Y, (const float*)(ws + WS_TPLE), ssq2, ssq3}; pg8::gemm_phase<EpiPleB, pg8::StaticOrder>(c.lds, g, S, E); }
        { const int kc = c.blk & 7;
          pg8::Gemm g{(const bf16*)(ws + WS_X2G) + kc * 256, (const bf16*)(ws + WS_WPG) + kc * 256, TT, DM, 256, DM}; TailOrder S{c.blk};
          EpiSlab E{(float*)(ws + WS_SLAB) + (size_t)kc * TS * DM};
          pg8::gemm_phase<EpiSlab, TailOrder>(c.lds, g, S, E); }
    } SEAM(11);
    PHASE(12) { REPSYNC();
        for (int m = c.blk * 8 + c.wave; m < TT; m += c.G * 8) {
            f32x4* yr = (f32x4*)(Y + (size_t)m * DM);
            if (m < TP) {
                const float rs = 1.f / sqrtf(ssq3[m] * (1.f / DM) + EPS);
#pragma unroll
                for (int j = 0; j < 8; ++j) { const f32x4 gq = ((const f32x4*)args.in[I_GFIN])[c.lane + 64 * j]; yr[c.lane + 64 * j] = yr[c.lane + 64 * j] * gq * rs; }
            } else {
                const int r = m - TP; const float rs2 = __builtin_amdgcn_rsqf(ssq2[m] * (1.f / DM) + EPS);
                const f32x4* tp = (const f32x4*)((const float*)(ws + WS_TPLE) + (size_t)m * DM);
                f32x4 x3[8]; float sq = 0.f;
#pragma unroll
                for (int j = 0; j < 8; ++j) { const int q = c.lane + 64 * j;
                    f32x4 v = (f32x4){0.f, 0.f, 0.f, 0.f};
#pragma unroll
                    for (int kc = 0; kc < 8; ++kc) v += ((const f32x4*)((const float*)(ws + WS_SLAB) + ((size_t)kc * TS + r) * DM))[q];
                    x3[j] = yr[q] + tp[q] * sig4(v * rs2);
                    sq += (x3[j][0] * x3[j][0] + x3[j][1] * x3[j][1]) + (x3[j][2] * x3[j][2] + x3[j][3] * x3[j][3]); }
                const float rs = 1.f / sqrtf(wave_sum(sq) * (1.f / DM) + EPS);
#pragma unroll
                for (int j = 0; j < 8; ++j) { const f32x4 gq = ((const f32x4*)args.in[I_GFIN])[c.lane + 64 * j]; yr[c.lane + 64 * j] = x3[j] * gq * rs; }
            }
        }
    }
#undef IN
#undef SEAM
}

extern "C" void kernel_launch(void* const* d_in, const int* in_sizes, int n_in, void* d_out, int out_size, void* d_ws, size_t ws_size, hipStream_t stream) {
    static int grid = 0;
    if (grid == 0) {
        if (n_in != 35 || out_size != (int)O_END || ws_size < WS_END) { fprintf(stderr, "kernel_launch: unexpected problem (n_in %d out %d ws %zu)\n", n_in, out_size, ws_size); grid = -1; return; }
        int dev = 0, cus = 0, per_cu = 0;
        if (hipGetDevice(&dev) != hipSuccess || hipDeviceGetAttribute(&cus, hipDeviceAttributeMultiprocessorCount, dev) != hipSuccess) { grid = -1; return; }
        if (hipFuncSetAttribute((const void*)fwd_megakernel, hipFuncAttributeMaxDynamicSharedMemorySize, LDS_BYTES) != hipSuccess) { fprintf(stderr, "kernel_launch: hipFuncSetAttribute failed\n"); grid = -1; return; }
        if (hipOccupancyMaxActiveBlocksPerMultiprocessor(&per_cu, (const void*)fwd_megakernel, 512, LDS_BYTES) != hipSuccess || per_cu < 1) { fprintf(stderr, "kernel_launch: occupancy query reports %d\n", per_cu); (void)hipGetLastError(); grid = -1; return; }
        grid = cus;
        if (grid != 256) { fprintf(stderr, "kernel_launch: unsupported CU count %d\n", cus); grid = -1; return; }
    }
    if (grid < 0) return;
    (void)hipMemsetAsync((char*)d_ws + WS_CTL, 0, CTL_ZERO_BYTES, stream);
    Args a{};
    for (int i = 0; i < 35; ++i) a.in[i] = (const float*)d_in[i];
    a.out = (float*)d_out; a.ws = (unsigned char*)d_ws;
    if (MK_N_LAUNCHES == 1) {
        a.ph_lo = 0; a.ph_hi = 13; a.li = 0;
        void* kargs[] = {&a};
        hipError_t e = hipLaunchCooperativeKernel((const void*)fwd_megakernel, dim3(grid), dim3(512), kargs, LDS_BYTES, stream);
        if (e != hipSuccess) fprintf(stderr, "kernel_launch: cooperative launch failed: %s\n", hipGetErrorString(e));
    } else {
        for (int p = 0; p < 13; ++p) { a.ph_lo = p; a.ph_hi = p + 1; a.li = p; hipLaunchKernelGGL(fwd_megakernel, dim3(grid), dim3(512), LDS_BYTES, stream, a); }
    }
}
```

```cpp
#include <hip/hip_runtime.h>
#include <cstdio>
#include <cstdint>

#ifndef MK_N_LAUNCHES
#define MK_N_LAUNCHES 1
#endif

#define LAS __attribute__((address_space(3)))
typedef unsigned short bf16;
typedef short bf16x8 __attribute__((ext_vector_type(8)));
typedef float f32x4 __attribute__((ext_vector_type(4)));
typedef float f32x2 __attribute__((ext_vector_type(2)));
typedef unsigned u32x4 __attribute__((ext_vector_type(4)));
typedef unsigned u32x2 __attribute__((ext_vector_type(2)));
typedef __bf16 bf2_t __attribute__((ext_vector_type(2)));

constexpr int DM = 2048, TP = 8192, TS = 1024, TT = 9216, SEQ = 2048, NBP = 4, NSB = 128, LSM = 8;
constexpr int NIN = 9232, NPROJ = 9216, NINP = 9472, FF = 5632, PLE = 256;
constexpr int NG = 64, NH = 8, HD = 128, CONVC = 3072, NCH = 32;
constexpr float EPS = 1e-6f;

constexpr size_t MiB = 1u << 20;
constexpr size_t WS_CTL = 0, CTL_ZERO_BYTES = 1 * MiB;
constexpr size_t WS_WIN = 1 * MiB, WS_WGLU = 38 * MiB, WS_WA = 40 * MiB, WS_WB = 44 * MiB, WS_WOUT = 48 * MiB, WS_WGU = 56 * MiB, WS_WDOWN = 100 * MiB, WS_WPLE = 122 * MiB, WS_WPG = 123 * MiB;
constexpr size_t WS_BA = 131 * MiB, WS_GL = 131 * MiB + 768 * 1024, WS_PB = 132 * MiB, WS_E = 137 * MiB;
constexpr size_t WS_HB = 141 * MiB, WS_YG = 141 * MiB, WS_YS = 159 * MiB, WS_X2G = 141 * MiB;
constexpr size_t WS_PROJ = 177 * MiB, WS_X1 = 177 * MiB, WS_X1G = 249 * MiB, WS_ACT = 285 * MiB, WS_TPLE = 285 * MiB;
constexpr size_t WS_YCAT = 1 * MiB;
constexpr size_t WS_SLAB = 1 * MiB;
constexpr size_t WS_O = 339 * MiB, WS_MIX = 339 * MiB, WS_YDN = 375 * MiB, WS_END = 393 * MiB;
constexpr int CW_BAR = 4096;
constexpr int CW_SSQ1 = 65536, CW_SSQ2 = 81920, CW_SSQ3 = 98304;
constexpr size_t O_Y = 0, O_CONVP = 18874368, O_DELTAP = 18911232, O_S5RP = 19435520, O_S5IP = 19451904, O_CONVS = 19468288, O_DELTAS = 20647936, O_S5RS = 37425152, O_S5IS = 37949440, O_END = 38473728;
constexpr size_t DN_ITEM = 73728, DN_W = 0, DN_QG = 16384, DN_KGT = 32768, DN_QK = 49152, DN_U = 57344;

constexpr int RING_BYTES = 131072, MISC_OFF = RING_BYTES + 320, LDS_BYTES = 147456;

__device__ __forceinline__ unsigned pk2(float a, float b) { bf2_t v; v.x = (__bf16)a; v.y = (__bf16)b; return __builtin_bit_cast(unsigned, v); }
__device__ __forceinline__ float bflo(unsigned w) { return __builtin_bit_cast(float, w << 16); }
__device__ __forceinline__ float bfhi(unsigned w) { return __builtin_bit_cast(float, w & 0xffff0000u); }
__device__ __forceinline__ float bf2f(bf16 h) { return __builtin_bit_cast(float, (unsigned)h << 16); }
__device__ __forceinline__ float sigmoidf_(float x) { return 1.f / (1.f + __expf(-x)); }
__device__ __forceinline__ float siluf_(float x) { return x / (1.f + __expf(-x)); }
__device__ __forceinline__ float gelu_tanh(float x) { const float z = 0.7978845608028654f * (x + 0.044715f * x * x * x); return x * __builtin_amdgcn_rcpf(1.f + __expf(-2.f * z)); }
__device__ __forceinline__ int permk(int x) { return (x & ~31) | (8 * ((x >> 2) & 3) + 4 * ((x >> 4) & 1) + (x & 3)); }
#define LDS_WAIT() asm volatile("s_waitcnt lgkmcnt(0)" ::: "memory")

struct Args {
    const float* in[35]; float* out; unsigned char* ws; int ph_lo, ph_hi, li, pad;
};
enum { I_XP = 0, I_XS, I_SCONV, I_SDELTA, I_S5RE, I_S5IM, I_PP, I_PS, I_GMIX, I_WIN, I_CONVW, I_ALOG, I_DTB, I_ONORM, I_S5AR, I_S5AI, I_S5BR, I_S5BI, I_S5CR, I_S5CI, I_S5D, I_S5LDT,
       I_WGLU, I_BGLU, I_WA, I_WB, I_WOUT, I_GFFN, I_WGATE, I_WUP, I_WDOWN, I_GPLE, I_WPLE, I_WPG, I_GFIN };

namespace pg8 {
constexpr int BM = 256, BK = 64, HALF = 128, HTB = HALF * BK * 2, NXCD = 8, WGM = 8;
__host__ __device__ __forceinline__ int lds_byte(int r, int c) { const int st = (r >> 4) * 2 + (c >> 5), rr = r & 15, cc = c & 31, ob = rr * 64 + cc * 2; return st * 1024 + (ob ^ (((ob >> 9) & 1) << 5)); }
__host__ __device__ __forceinline__ void stage_rc(int b, int& R, int& C) { const int st = b / 1024, sb = b % 1024, swz = sb ^ (((sb >> 9) & 1) << 5); R = (st >> 1) * 16 + swz / 64; C = (st & 1) * 32 + (swz % 64) / 2; }
__host__ __device__ __forceinline__ int perm32(int rho) { const int n = rho >> 4, i = rho & 15; return 8 * (i >> 2) + 4 * n + (i & 3); }
struct Unit { int pm, pn; };
struct Gemm { const bf16* A; const bf16* Bt; int M, N, K; int ld; };
struct StaticOrder {
    int nM, nN, nwg, G, c;
    __host__ __device__ void init(int M, int N, int G_, int c_) { nM = M / BM; nN = N / BM; nwg = nM * nN; G = G_; c = c_; }
    __host__ __device__ bool next(int i, Unit& u) const {
        const long L = (long)i * G + c; if (L >= nwg) return false;
        int wgid = (int)L; { const int q = nwg / NXCD, r = nwg % NXCD, xcd = wgid % NXCD, off = wgid / NXCD; wgid = (xcd < r ? xcd * (q + 1) : r * (q + 1) + (xcd - r) * q) + off; }
        const int nig = WGM * nN, gid = wgid / nig, fm = gid * WGM, gsz = (nM - fm) < WGM ? (nM - fm) : WGM;
        u.pm = fm + ((wgid % nig) % gsz); u.pn = (wgid % nig) / gsz; return true;
    }
    __device__ __forceinline__ void a_ready(const Unit&) const {}
    __device__ __forceinline__ void done(const Unit&) const {}
};

template <class Epi, class Sched, bool ALIGN_EPI = true, bool SP2 = true>
__device__ __forceinline__ void gemm_phase(LAS unsigned char* lds, const Gemm g, const Sched& S, const Epi& E) {
    int tid = threadIdx.x; asm volatile("" : "+v"(tid));
    const int wid = __builtin_amdgcn_readfirstlane(tid >> 6), lane = tid & 63, wr = wid >> 2, wc = wid & 3, fr = lane & 15, fq = lane >> 4;
    const int K = g.ld ? g.ld : g.K, nt = g.K / BK;
    unsigned voffA[2], voffB[2];
#pragma unroll
    for (int i = 0; i < 2; ++i) { int R, C; stage_rc(tid * 16 + i * 8192, R, C); const int Rb = Epi::PERM ? ((R & ~31) + perm32(R & 31)) : R;
        voffA[i] = (unsigned)(R * K + C) * 2u; voffB[i] = (unsigned)(Rb * K + C) * 2u; }
    const size_t kstep = (size_t)(BK * 2);
    const size_t hstep = (size_t)HALF * K * 2;
    const size_t tstep = 2 * hstep;
    const unsigned ldsw = (unsigned)wid * 1024u;
    const int aoff = lds_byte(wr * 64 + fr, fq * 8), boff = lds_byte(wc * 32 + fr, fq * 8);
#define PG8_SA(b, h) (((b) * 2 + (h)) * HTB)
#define PG8_SB(b, h) ((4 + (b) * 2 + (h)) * HTB)
#define PG8_STAGE(bufoff, gbase, voff) do { _Pragma("unroll") for (int _i = 0; _i < 2; ++_i) \
        __builtin_amdgcn_global_load_lds((const unsigned*)((const char*)(gbase) + (voff)[_i]), (LAS unsigned*)(lds + (bufoff) + ldsw + _i * 8192), 16, 0, 0); } while (0)
#define PG8_LDA(dst, b, h) do { _Pragma("unroll") for (int m = 0; m < 4; ++m) _Pragma("unroll") for (int k = 0; k < 2; ++k) dst[m][k] = *(const LAS bf16x8*)(lds + PG8_SA(b, h) + aoff + m * 2048 + k * 1024); } while (0)
#define PG8_LDB(dst, b, h) do { _Pragma("unroll") for (int n = 0; n < 2; ++n) _Pragma("unroll") for (int k = 0; k < 2; ++k) dst[n][k] = *(const LAS bf16x8*)(lds + PG8_SB(b, h) + boff + n * 2048 + k * 1024); } while (0)
#define PG8_MMA(ai, bj, At, Bt) do { __builtin_amdgcn_s_setprio(1); _Pragma("unroll") for (int m = 0; m < 4; ++m) _Pragma("unroll") for (int n = 0; n < 2; ++n) _Pragma("unroll") for (int k = 0; k < 2; ++k) \
        acc[ai][bj][m][n] = __builtin_amdgcn_mfma_f32_16x16x32_bf16(Bt[n][k], At[m][k], acc[ai][bj][m][n], 0, 0, 0); __builtin_amdgcn_s_setprio(0); } while (0)
#define PG8_WAIT_V(n) asm volatile("s_waitcnt vmcnt(" #n ")" ::: "memory")
#define PG8_WAIT_L(n) asm volatile("s_waitcnt lgkmcnt(" #n ")" ::: "memory")
#define PG8_BAR __builtin_amdgcn_s_barrier()
#define PG8_SCHED __builtin_amdgcn_sched_barrier(0)
    Unit cur, nxt; int ui = 0;
    if (!S.next(0, cur)) return;
    f32x4 acc[2][2][4][2];
#pragma unroll
    for (int a = 0; a < 2; ++a)
#pragma unroll
        for (int b = 0; b < 2; ++b)
#pragma unroll
            for (int m = 0; m < 4; ++m)
#pragma unroll
                for (int n = 0; n < 2; ++n) acc[a][b][m][n] = (f32x4){0.f, 0.f, 0.f, 0.f};
    bf16x8 At[4][2], B0[2][2], B1[2][2];
    const char* cA = (const char*)g.A + (size_t)cur.pm * tstep; const char* cB = (const char*)g.Bt + (size_t)cur.pn * tstep;
    S.a_ready(cur);
    if constexpr (SP2) {
        PG8_STAGE(PG8_SB(0, 0), cB, voffB); PG8_STAGE(PG8_SB(0, 1), cB + hstep, voffB); PG8_STAGE(PG8_SA(0, 0), cA, voffA); PG8_STAGE(PG8_SA(0, 1), cA + hstep, voffA);
        if (wr == 1) PG8_BAR;
        PG8_WAIT_V(2); PG8_BAR;
        PG8_STAGE(PG8_SB(1, 0), cB + kstep, voffB); PG8_STAGE(PG8_SA(1, 0), cA + kstep, voffA); PG8_STAGE(PG8_SB(1, 1), cB + hstep + kstep, voffB);
        PG8_WAIT_V(6); PG8_BAR;
    } else {
        PG8_STAGE(PG8_SB(0, 0), cB, voffB); PG8_STAGE(PG8_SA(0, 0), cA, voffA); PG8_STAGE(PG8_SB(0, 1), cB + hstep, voffB); PG8_STAGE(PG8_SA(0, 1), cA + hstep, voffA);
        if (wr == 1) PG8_BAR;
        PG8_WAIT_V(4); PG8_BAR;
        PG8_STAGE(PG8_SB(1, 0), cB + kstep, voffB); PG8_STAGE(PG8_SA(1, 0), cA + kstep, voffA); PG8_STAGE(PG8_SB(1, 1), cB + hstep + kstep, voffB);
        PG8_WAIT_V(6); PG8_BAR;
    }
    for (;;) {
        const bool has_next = S.next(ui + 1, nxt);
        const char* nA = has_next ? (const char*)g.A + (size_t)nxt.pm * tstep : cA; const char* nB = has_next ? (const char*)g.Bt + (size_t)nxt.pn * tstep : cB;
        for (int t = 0; t < nt; t += 2) {
            const bool last = (t == nt - 2);
            const char* a1 = cA + (size_t)(t + 1) * kstep;
            const char* a2 = last ? nA : cA + (size_t)(t + 2) * kstep; const char* b2 = last ? nB : cB + (size_t)(t + 2) * kstep;
            const char* a3 = a2 + kstep; const char* b3 = b2 + kstep;
            if (last && has_next) S.a_ready(nxt);
            if constexpr (Epi::MID_T >= 0) { if (t == Epi::MID_T) E.mid(acc, cur, wr, wc, fr, fq); }
            if constexpr (SP2) {
            PG8_LDB(B0, 0, 0); PG8_LDB(B1, 0, 1); PG8_SCHED; PG8_LDA(At, 0, 0); PG8_STAGE(PG8_SA(1, 1), a1 + hstep, voffA);
            PG8_WAIT_V(8); PG8_WAIT_L(0); PG8_BAR; PG8_MMA(0, 0, At, B0); PG8_MMA(0, 1, At, B1); PG8_BAR; PG8_SCHED;
            PG8_LDA(At, 0, 1); PG8_STAGE(PG8_SB(0, 0), b2, voffB); PG8_STAGE(PG8_SB(0, 1), b2 + hstep, voffB); PG8_STAGE(PG8_SA(0, 0), a2, voffA);
            PG8_WAIT_V(8); PG8_WAIT_L(0); PG8_BAR; PG8_MMA(1, 0, At, B0); PG8_MMA(1, 1, At, B1); PG8_BAR; PG8_SCHED;
            PG8_LDB(B0, 1, 0); PG8_LDB(B1, 1, 1); PG8_SCHED; PG8_LDA(At, 1, 0); PG8_STAGE(PG8_SA(0, 1), a2 + hstep, voffA);
            PG8_WAIT_V(8); PG8_WAIT_L(0); PG8_BAR; PG8_MMA(0, 0, At, B0); PG8_MMA(0, 1, At, B1); PG8_BAR; PG8_SCHED;
            PG8_LDA(At, 1, 1); PG8_STAGE(PG8_SB(1, 0), b3, voffB); PG8_STAGE(PG8_SB(1, 1), b3 + hstep, voffB); PG8_STAGE(PG8_SA(1, 0), a3, voffA);
            PG8_WAIT_V(8); PG8_WAIT_L(0); PG8_BAR; PG8_MMA(1, 0, At, B0); PG8_MMA(1, 1, At, B1); PG8_BAR; PG8_SCHED;
            } else {
            PG8_LDB(B0, 0, 0); PG8_SCHED; PG8_LDA(At, 0, 0); PG8_STAGE(PG8_SA(1, 1), a1 + hstep, voffA);
            PG8_WAIT_L(8); PG8_BAR; PG8_WAIT_L(0); PG8_MMA(0, 0, At, B0); PG8_BAR; PG8_SCHED;
            PG8_LDB(B1, 0, 1); PG8_STAGE(PG8_SB(0, 0), b2, voffB);
            PG8_BAR; PG8_WAIT_L(0); PG8_MMA(0, 1, At, B1); PG8_BAR;
            PG8_LDA(At, 0, 1); PG8_STAGE(PG8_SA(0, 0), a2, voffA);
            PG8_BAR; PG8_WAIT_L(0); PG8_MMA(1, 0, At, B0); PG8_BAR; PG8_SCHED;
            PG8_STAGE(PG8_SB(0, 1), b2 + hstep, voffB);
            PG8_WAIT_V(6); PG8_BAR; PG8_MMA(1, 1, At, B1); PG8_BAR;
            PG8_LDB(B0, 1, 0); PG8_SCHED; PG8_LDA(At, 1, 0); PG8_STAGE(PG8_SA(0, 1), a2 + hstep, voffA);
            PG8_WAIT_L(8); PG8_BAR; PG8_WAIT_L(0); PG8_MMA(0, 0, At, B0); PG8_BAR; PG8_SCHED;
            PG8_LDB(B1, 1, 1); PG8_STAGE(PG8_SB(1, 0), b3, voffB);
            PG8_BAR; PG8_WAIT_L(0); PG8_MMA(0, 1, At, B1); PG8_BAR;
            PG8_LDA(At, 1, 1); PG8_STAGE(PG8_SA(1, 0), a3, voffA);
            PG8_BAR; PG8_WAIT_L(0); PG8_MMA(1, 0, At, B0); PG8_BAR; PG8_SCHED;
            PG8_STAGE(PG8_SB(1, 1), b3 + hstep, voffB);
            PG8_WAIT_V(6); PG8_BAR; PG8_MMA(1, 1, At, B1); PG8_BAR;
            }
        }
        if constexpr (ALIGN_EPI) { if (wr == 0) PG8_BAR; }
        E(acc, cur, wr, wc, fr, fq); S.done(cur);
        if (!has_next) break;
#pragma unroll
        for (int a = 0; a < 2; ++a)
#pragma unroll
            for (int b = 0; b < 2; ++b)
#pragma unroll
                for (int m = 0; m < 4; ++m)
#pragma unroll
                    for (int n = 0; n < 2; ++n) acc[a][b][m][n] = (f32x4){0.f, 0.f, 0.f, 0.f};
        cur = nxt; cA = nA; cB = nB; ++ui;
        if constexpr (ALIGN_EPI) { if (wr == 1) PG8_BAR; }
    }
    PG8_WAIT_V(0);
    if constexpr (!ALIGN_EPI) { if (wr == 0) PG8_BAR; }
    PG8_BAR;
#undef PG8_SA
#undef PG8_SB
#undef PG8_STAGE
#undef PG8_LDA
#undef PG8_LDB
#undef PG8_MMA
#undef PG8_WAIT_V
#undef PG8_WAIT_L
#undef PG8_BAR
#undef PG8_SCHED
}
}

typedef f32x4 AccT[2][2][4][2];
#define EPI_ROWS_BEGIN  _Pragma("unroll") for (int ai = 0; ai < 2; ++ai) _Pragma("unroll") for (int m = 0; m < 4; ++m) { const int row = u.pm * 256 + ai * 128 + wr * 64 + m * 16 + fr;
#define EPI_ROWS_END    asm volatile("" ::: "memory"); }
__device__ __forceinline__ u32x4 pack8(const f32x4 a, const f32x4 b) { u32x4 w; w.x = pk2(a[0], a[1]); w.y = pk2(a[2], a[3]); w.z = pk2(b[0], b[1]); w.w = pk2(b[2], b[3]); return w; }
__device__ __forceinline__ void unpack8(const u32x4 w, f32x4& a, f32x4& b) { a = (f32x4){bflo(w.x), bfhi(w.x), bflo(w.y), bfhi(w.y)}; b = (f32x4){bflo(w.z), bfhi(w.z), bflo(w.w), bfhi(w.w)}; }
__device__ __forceinline__ f32x4 sig4(f32x4 v) { return (f32x4){sigmoidf_(v[0]), sigmoidf_(v[1]), sigmoidf_(v[2]), sigmoidf_(v[3])}; }
__device__ __forceinline__ float ssq8(const f32x4 a, const f32x4 b) { return (a[0] * a[0] + a[1] * a[1]) + (a[2] * a[2] + a[3] * a[3]) + (b[0] * b[0] + b[1] * b[1]) + (b[2] * b[2] + b[3] * b[3]); }

struct EpiProj {
    static constexpr bool PERM = true; static constexpr int MID_T = -1;
    bf16* P; float* BA;
    __device__ __forceinline__ void operator()(const AccT& acc, const pg8::Unit& u, int wr, int wc, int fr, int fq) const {
        if (u.pn < 36) {
            const int col0 = u.pn * 256 + wc * 32 + 8 * fq;
            EPI_ROWS_BEGIN
                bf16* rp = P + (size_t)row * NPROJ + col0;
#pragma unroll
                for (int bj = 0; bj < 2; ++bj) *(u32x4*)(rp + bj * 128) = pack8(acc[ai][bj][m][0], acc[ai][bj][m][1]);
            EPI_ROWS_END
        } else if (wc == 0 && fq < 2) {
            EPI_ROWS_BEGIN
                float* rp = BA + (size_t)row * 16 + 8 * fq;
                *(f32x4*)rp = acc[ai][0][m][0]; *(f32x4*)(rp + 4) = acc[ai][0][m][1];
            EPI_ROWS_END
        }
    }
};
struct EpiGlu {
    static constexpr bool PERM = true; static constexpr int MID_T = -1;
    const bf16* YG; bf16* YS; const float* bias;
    __device__ __forceinline__ void operator()(const AccT& acc, const pg8::Unit& u, int wr, int wc, int fr, int fq) const {
        const int col0 = u.pn * 256 + wc * 32 + 8 * fq;
        f32x4 bv[2][2];
#pragma unroll
        for (int bj = 0; bj < 2; ++bj) { bv[bj][0] = *(const f32x4*)(bias + col0 + bj * 128); bv[bj][1] = *(const f32x4*)(bias + col0 + bj * 128 + 4); }
        EPI_ROWS_BEGIN
#pragma unroll
            for (int bj = 0; bj < 2; ++bj) { const size_t off = (size_t)row * 1024 + col0 + bj * 128;
                f32x4 y0, y1; unpack8(*(const u32x4*)(YG + off), y0, y1);
                const f32x4 o0 = y0 * sig4(acc[ai][bj][m][0] + bv[bj][0]), o1 = y1 * sig4(acc[ai][bj][m][1] + bv[bj][1]);
                *(u32x4*)(YS + (size_t)row * DM + col0 + bj * 128) = pack8(o0, o1); }
        EPI_ROWS_END
    }
};
struct EpiMix {
    static constexpr bool PERM = true; static constexpr int MID_T = 16;
    const bf16* P; bf16* MIX;
    __device__ __forceinline__ void mid(AccT& acc, const pg8::Unit& u, int wr, int wc, int fr_, int fq) const {
        int fr = fr_; asm volatile("" : "+v"(fr));
        const int col0 = u.pn * 256 + wc * 32 + 8 * fq;
        EPI_ROWS_BEGIN
            const bf16* gp = P + (size_t)row * NPROJ + 5120 + col0;
#pragma unroll
            for (int bj = 0; bj < 2; ++bj) {
                f32x4 a0, a1, b0, b1; unpack8(*(const u32x4*)(gp + bj * 128), a0, a1); unpack8(*(const u32x4*)(gp + 2048 + bj * 128), b0, b1);
#pragma unroll
                for (int q = 0; q < 4; ++q) { acc[ai][bj][m][0][q] *= (1.f + __expf(-b0[q])) * __builtin_amdgcn_rcpf(1.f + __expf(-a0[q])); acc[ai][bj][m][1][q] *= (1.f + __expf(-b1[q])) * __builtin_amdgcn_rcpf(1.f + __expf(-a1[q])); }
                asm volatile("" ::: "memory"); }
        EPI_ROWS_END
    }
    __device__ __forceinline__ void operator()(const AccT& acc, const pg8::Unit& u, int wr, int wc, int fr, int fq) const {
        const int col0 = u.pn * 256 + wc * 32 + 8 * fq;
        EPI_ROWS_BEGIN
#pragma unroll
            for (int bj = 0; bj < 2; ++bj) { const int c = col0 + bj * 128;
                f32x4 g0, g1; unpack8(*(const u32x4*)(P + (size_t)row * NPROJ + 7168 + c), g0, g1);
                *(u32x4*)(MIX + (size_t)row * DM + c) = pack8(sig4(g0) * acc[ai][bj][m][0], sig4(g1) * acc[ai][bj][m][1]); }
        EPI_ROWS_END
    }
};
struct EpiResid {
    static constexpr bool PERM = true; static constexpr int MID_T = -1;
    const float* b0; const float* b1; float* XO; bf16* XG; const float* gw; float* ssq;
    __device__ __forceinline__ void operator()(const AccT& acc, const pg8::Unit& u, int wr, int wc, int fr, int fq) const {
        const int col0 = u.pn * 256 + wc * 32 + 8 * fq;
        f32x4 gv[2][2];
#pragma unroll
        for (int bj = 0; bj < 2; ++bj) { gv[bj][0] = *(const f32x4*)(gw + col0 + bj * 128); gv[bj][1] = *(const f32x4*)(gw + col0 + bj * 128 + 4); }
        EPI_ROWS_BEGIN
            const float* bp = (row < TP ? b0 + (size_t)row * DM : b1 + (size_t)(row - TP) * DM) + col0;
            float s = 0.f;
#pragma unroll
            for (int bj = 0; bj < 2; ++bj) { const int c = col0 + bj * 128;
                const f32x4 o0 = *(const f32x4*)(bp + bj * 128) + acc[ai][bj][m][0], o1 = *(const f32x4*)(bp + bj * 128 + 4) + acc[ai][bj][m][1];
                float* xp = XO + (size_t)row * DM + c; *(f32x4*)xp = o0; *(f32x4*)(xp + 4) = o1;
                *(u32x4*)(XG + (size_t)row * DM + c) = pack8(o0 * gv[bj][0], o1 * gv[bj][1]);
                s += ssq8(o0, o1); }
            s += __shfl_xor(s, 16); s += __shfl_xor(s, 32);
            if (fq == 0) atomicAdd(ssq + row, s);
        EPI_ROWS_END
    }
};
struct EpiGU {
    static constexpr bool PERM = true; static constexpr int MID_T = -1;
    const float* ssq; bf16* ACT;
    __device__ __forceinline__ void operator()(const AccT& acc, const pg8::Unit& u, int wr, int wc, int fr, int fq) const {
        const int col0 = u.pn * 128 + wc * 32 + 8 * fq;
        EPI_ROWS_BEGIN
            const float rs = __builtin_amdgcn_rsqf(ssq[row] * (1.f / DM) + EPS);
            f32x4 o[2];
#pragma unroll
            for (int n = 0; n < 2; ++n) { const f32x4 g = acc[ai][0][m][n] * rs, up = acc[ai][1][m][n] * rs;
                o[n] = (f32x4){siluf_(g[0]) * up[0], siluf_(g[1]) * up[1], siluf_(g[2]) * up[2], siluf_(g[3]) * up[3]}; }
            *(u32x4*)(ACT + (size_t)row * FF + col0) = pack8(o[0], o[1]);
        EPI_ROWS_END
    }
};
struct EpiF32 {
    static constexpr bool PERM = true; static constexpr int MID_T = -1;
    float* C;
    __device__ __forceinline__ void operator()(const AccT& acc, const pg8::Unit& u, int wr, int wc, int fr, int fq) const {
        const int col0 = u.pn * 256 + wc * 32 + 8 * fq;
        EPI_ROWS_BEGIN
#pragma unroll
            for (int bj = 0; bj < 2; ++bj) { float* tp = C + (size_t)row * DM + col0 + bj * 128; *(f32x4*)tp = acc[ai][bj][m][0]; *(f32x4*)(tp + 4) = acc[ai][bj][m][1]; }
        EPI_ROWS_END
    }
};
struct TailOrder {
    int c;
    __device__ bool next(int i, pg8::Unit& u) const { if (i != 0) return false; u.pm = 32 + (c >> 6); u.pn = (c >> 3) & 7; return true; }
    __device__ __forceinline__ void a_ready(const pg8::Unit&) const {}
    __device__ __forceinline__ void done(const pg8::Unit&) const {}
};
struct EpiSlab {
    static constexpr bool PERM = true; static constexpr int MID_T = -1;
    float* C;
    __device__ __forceinline__ void operator()(const AccT& acc, const pg8::Unit& u, int wr, int wc, int fr, int fq) const {
        const int col0 = u.pn * 256 + wc * 32 + 8 * fq;
        EPI_ROWS_BEGIN
#pragma unroll
            for (int bj = 0; bj < 2; ++bj) { float* tp = C + (size_t)(row - TP) * DM + col0 + bj * 128; *(f32x4*)tp = acc[ai][bj][m][0]; *(f32x4*)(tp + 4) = acc[ai][bj][m][1]; }
        EPI_ROWS_END
    }
};
struct EpiPleB {
    static constexpr bool PERM = true; static constexpr int MID_T = -1;
    float* X; const float* TPLE; const float* ssq_in; float* ssq_out;
    __device__ __forceinline__ void operator()(const AccT& acc, const pg8::Unit& u, int wr, int wc, int fr, int fq) const {
        const int col0 = u.pn * 256 + wc * 32 + 8 * fq;
        EPI_ROWS_BEGIN
            const float rs = __builtin_amdgcn_rsqf(ssq_in[row] * (1.f / DM) + EPS);
            float s = 0.f;
            float* xp = X + (size_t)row * DM + col0; const float* tp = TPLE + (size_t)row * DM + col0;
#pragma unroll
            for (int bj = 0; bj < 2; ++bj) {
#pragma unroll
                for (int n = 0; n < 2; ++n) { const f32x4 o = *(const f32x4*)(xp + bj * 128 + 4 * n) + *(const f32x4*)(tp + bj * 128 + 4 * n) * sig4(acc[ai][bj][m][n] * rs);
                    *(f32x4*)(xp + bj * 128 + 4 * n) = o; s += (o[0] * o[0] + o[1] * o[1]) + (o[2] * o[2] + o[3] * o[3]); asm volatile("" ::: "memory"); } }
            s += __shfl_xor(s, 16); s += __shfl_xor(s, 32);
            if (fq == 0) atomicAdd(ssq_out + row, s);
        EPI_ROWS_END
    }
};

#define XB_TMO      128
#define XB_XCNT(j)  (256  + 64 * (j))
#define XB_XSUB(j)  (1280 + 64 * (j))
#define XB_XGEN(j)  (2304 + 64 * (j))
#define XB_TOP      3328
#define XB_TOPGEN   3392
#define XCD_BAR_WORDS 3456
#define XB_SPIN_CAP (1u << 20)
__device__ __forceinline__ unsigned xb_ld(unsigned* p)              { return __hip_atomic_load(p, __ATOMIC_RELAXED, __HIP_MEMORY_SCOPE_AGENT); }
__device__ __forceinline__ unsigned xb_add(unsigned* p, unsigned v) { return __hip_atomic_fetch_add(p, v, __ATOMIC_RELAXED, __HIP_MEMORY_SCOPE_AGENT); }
__device__ __forceinline__ unsigned xb_xcc_id() { return (unsigned)__builtin_amdgcn_s_getreg((3 << 11) | 20) & 0xFu; }
#define XB_SPIN(cond, bar) do { unsigned _sp = 0; while (cond) { __builtin_amdgcn_s_sleep(1); \
    if ((++_sp & 255u) == 0u) { if (xb_ld(&(bar)[XB_TMO])) break; if (_sp > XB_SPIN_CAP) { atomicAdd(&(bar)[XB_TMO], 1u); break; } } } } while (0)
struct XcdBarrier { unsigned* bar; unsigned x; volatile LAS unsigned* st; };
__device__ __forceinline__ XcdBarrier xcd_barrier_post(unsigned* bar, volatile LAS unsigned* st) {
    XcdBarrier b; b.bar = bar; b.x = xb_xcc_id(); b.st = st;
    if (threadIdx.x == 0) (void)xb_add(&bar[XB_XCNT(b.x)], 1u);
    return b;
}
__device__ __forceinline__ void xcd_barrier_complete(unsigned* bar, unsigned x, unsigned& nloc, unsigned& nx) {
    const unsigned G = gridDim.x * gridDim.y * gridDim.z;
    unsigned sum, cnt, mine, sp = 0u;
    for (;;) {
        sum = 0u; cnt = 0u; mine = 0u;
#pragma unroll
        for (unsigned j = 0; j < 16; ++j) { const unsigned c = xb_ld(&bar[XB_XCNT(j)]); sum += c; cnt += (c > 0u) ? 1u : 0u; mine = (j == x) ? c : mine; }
        if (sum == G) break;
        __builtin_amdgcn_s_sleep(1);
        if ((++sp & 255u) == 0u) { if (xb_ld(&bar[XB_TMO])) break; if (sp > XB_SPIN_CAP) { atomicAdd(&bar[XB_TMO], 1u); break; } }
    }
    nloc = mine > 0u ? mine : 1u; nx = cnt > 0u ? cnt : 1u;
}
__device__ __forceinline__ void xcd_barrier(const XcdBarrier& b) {
    asm volatile("s_waitcnt vmcnt(0)" ::: "memory");
    __syncthreads();
    if (threadIdx.x == 0) {
        unsigned* bar = b.bar;
        __builtin_amdgcn_s_waitcnt(0);
        unsigned nloc = b.st[0], nx = b.st[1];
        if (nloc == 0u) { xcd_barrier_complete(bar, b.x, nloc, nx); b.st[0] = nloc; b.st[1] = nx; }
        const unsigned old = xb_add(&bar[XB_XSUB(b.x)], 1u);
        const unsigned gen = old / nloc;
        if (old + 1u == (gen + 1u) * nloc) {
            __builtin_amdgcn_fence(__ATOMIC_RELEASE, "agent");
            asm volatile("s_waitcnt vmcnt(0)" ::: "memory");
            const unsigned og = xb_add(&bar[XB_TOP], 1u);
            const unsigned tg = og / nx;
            if (og + 1u == (tg + 1u) * nx) xb_add(&bar[XB_TOPGEN], 1u);
            else XB_SPIN(xb_ld(&bar[XB_TOPGEN]) == tg, bar);
            __builtin_amdgcn_fence(__ATOMIC_ACQUIRE, "agent");
            xb_add(&bar[XB_XGEN(b.x)], 1u);
            asm volatile("s_waitcnt vmcnt(0)" ::: "memory");
        } else {
            XB_SPIN(xb_ld(&bar[XB_XGEN(b.x)]) == gen, bar);
            __builtin_amdgcn_fence(__ATOMIC_ACQUIRE, "agent");
            asm volatile("s_waitcnt vmcnt(0)" ::: "memory");
        }
    }
    __syncthreads();
}

__device__ __forceinline__ float wave_sum(float v) {
#pragma unroll
    for (int o = 1; o < 64; o <<= 1) v += __shfl_xor(v, o);
    return v;
}
__device__ __forceinline__ void tr_item(const float* W, int ldw, int c0, int k0, bf16* WT, int K, int r0, int nw, LAS float* scr, int lane) {
    const int nn = lane & 31;
    float tv[32];
    const float* src = W + (size_t)(k0 + (lane >> 5)) * ldw + c0 + nn;
#pragma unroll
    for (int i = 0; i < 32; ++i) tv[i] = (nn < nw) ? __builtin_nontemporal_load(src + (size_t)(2 * i) * ldw) : 0.f;
#pragma unroll
    for (int i = 0; i < 32; ++i) scr[(2 * i + (lane >> 5)) * 33 + nn] = tv[i];
    LDS_WAIT(); asm volatile("" ::: "memory");
    const int c = lane & 7;
#pragma unroll
    for (int j = 0; j < 4; ++j) { const int n = (lane >> 3) + 8 * j; const LAS float* s = scr + (8 * c) * 33 + n;
        u32x4 o; o.x = pk2(s[0 * 33], s[1 * 33]); o.y = pk2(s[2 * 33], s[3 * 33]); o.z = pk2(s[4 * 33], s[5 * 33]); o.w = pk2(s[6 * 33], s[7 * 33]);
        if (n < nw) *(u32x4*)(WT + (size_t)(r0 + n) * K + k0 + 8 * c) = o; }
    LDS_WAIT(); asm volatile("" ::: "memory");
}

__device__ __forceinline__ f32x2 cmul(f32x2 a, f32x2 b) { return (f32x2){a[0] * b[0] - a[1] * b[1], a[0] * b[1] + a[1] * b[0]}; }
__device__ __forceinline__ f32x2 cfma(f32x2 a, f32x2 b, f32x2 c) {
    const f32x2 bx = __builtin_shufflevector(b, b, 0, 0), by = __builtin_shufflevector(b, b, 1, 1);
    const f32x2 ar = (f32x2){-a[1], a[0]};
    return __builtin_elementwise_fma(bx, a, __builtin_elementwise_fma(by, ar, c));
}
__device__ __forceinline__ f32x2 shfl2(f32x2 v, int src) { return (f32x2){__shfl(v[0], src), __shfl(v[1], src)}; }
__device__ __forceinline__ f32x2 shflup2(f32x2 v, int d) { return (f32x2){__shfl_up(v[0], d), __shfl_up(v[1], d)}; }
__device__ __forceinline__ float bf_round(float x) { return bflo(pk2(x, 0.f)); }
struct S5W { f32x2 lam[4], lam4[4], lam8[4], lamin[4]; bf16x8 bf[8]; };
__device__ __forceinline__ void s5_state_params(const Args& a, int g, int n, f32x2& lam, f32x2& cc) {
    const float dt = expf(a.in[I_S5LDT][g]);
    const float ar = a.in[I_S5AR][g * 64 + n], ai = a.in[I_S5AI][g * 64 + n];
    const float mag = expf(ar * dt);
    const double x = (double)ai * (double)dt;
    const double kq = rint(x * 0.15915494309189535), r = x - kq * 6.283185307179586, r2 = r * r;
    double ts = r, ss = r, tc = 1.0, sc = 1.0;
#pragma unroll
    for (int k = 0; k < 12; ++k) { ts *= -r2 * (1.0 / (double)((2 * k + 2) * (2 * k + 3))); ss += ts; tc *= -r2 * (1.0 / (double)((2 * k + 1) * (2 * k + 2))); sc += tc; }
    const float lr = mag * (float)sc, li = mag * (float)ss;
    const float nr = lr - 1.f, ni = li, den = ar * ar + ai * ai;
    lam = (f32x2){lr, li}; cc = (f32x2){(nr * ar + ni * ai) / den, (ni * ar - nr * ai) / den};
}
__device__ __forceinline__ void s5_setup(const Args& a, int g, int l, S5W& W, const f32x2 lamS, const f32x2 ccS) {
    const int col = l & 15, rg = l >> 4;
#pragma unroll
    for (int j = 0; j < 4; ++j) {
        const int n = 16 * j + col;
        const f32x2 lam = shfl2(lamS, n), cj = shfl2(ccS, n);
        const f32x2 l2 = cmul(lam, lam), l4 = cmul(l2, l2), l8 = cmul(l4, l4);
        W.lam[j] = lam; W.lam4[j] = rg >= 1 ? l4 : (f32x2){0.f, 0.f}; W.lam8[j] = rg >= 2 ? l8 : (f32x2){0.f, 0.f};
        W.lamin[j] = rg == 0 ? (f32x2){1.f, 0.f} : rg == 1 ? l4 : rg == 2 ? l8 : cmul(l8, l4);
        const float* br = a.in[I_S5BR] + (size_t)(g * 64 + n) * 16 + 8 * (rg & 1); const float* bi = a.in[I_S5BI] + (size_t)(g * 64 + n) * 16 + 8 * (rg & 1);
        const f32x4 r0 = *(const f32x4*)br, r1 = *(const f32x4*)(br + 4), i0 = *(const f32x4*)bi, i1 = *(const f32x4*)(bi + 4);
        f32x4 xr0 = r0 * cj[0] - i0 * cj[1], xr1 = r1 * cj[0] - i1 * cj[1], xi0 = i0 * cj[0] + r0 * cj[1], xi1 = i1 * cj[0] + r1 * cj[1];
        if (rg >= 2) {
#pragma unroll
            for (int q = 0; q < 4; ++q) { xr0[q] -= bf_round(xr0[q]); xr1[q] -= bf_round(xr1[q]); xi0[q] -= bf_round(xi0[q]); xi1[q] -= bf_round(xi1[q]); }
        }
        W.bf[j] = __builtin_bit_cast(bf16x8, pack8(xr0, xr1)); W.bf[4 + j] = __builtin_bit_cast(bf16x8, pack8(xi0, xi1));
    }
}
__device__ __forceinline__ u32x4 s5_load_u(const bf16* PROJ, int tok0, int g, int nvalid, int l) {
    const int col = l & 15, rg = l >> 4;
    u32x4 au = (u32x4){0u, 0u, 0u, 0u};
    if (col < nvalid) au = *(const u32x4*)(PROJ + (size_t)(tok0 + col) * NPROJ + g * 16 + 8 * (rg & 1));
    return au;
}
__device__ __forceinline__ void s5_bu_tile(const u32x4 au, const S5W& W, f32x4 (&d)[8]) {
    const bf16x8 av = __builtin_bit_cast(bf16x8, au);
#pragma unroll
    for (int jt = 0; jt < 8; ++jt) d[jt] = __builtin_amdgcn_mfma_f32_16x16x32_bf16(av, W.bf[jt], (f32x4){0.f, 0.f, 0.f, 0.f}, 0, 0, 0);
}
__device__ __forceinline__ void s5_scan_block(const S5W& W, int j, int rg, const f32x4& dre, const f32x4& dim, f32x2 hin, f32x2 (&h)[4]) {
    const f32x2 b0 = (f32x2){dre[0], dim[0]}, b1 = (f32x2){dre[1], dim[1]}, b2 = (f32x2){dre[2], dim[2]}, b3 = (f32x2){dre[3], dim[3]};
    const f32x2 l3 = cfma(W.lam[j], cfma(W.lam[j], cfma(W.lam[j], b0, b1), b2), b3);
    f32x2 P = l3, t;
    t = shflup2(P, 16); P = cfma(W.lam4[j], t, P);
    t = shflup2(P, 32); P = cfma(W.lam8[j], t, P);
    const float m1 = rg >= 1 ? 1.f : 0.f;
    const f32x2 e = shflup2(P, 16) * m1;
    const f32x2 cin = cfma(W.lamin[j], hin, e);
    h[0] = cfma(W.lam[j], cin, b0); h[1] = cfma(W.lam[j], h[0], b1); h[2] = cfma(W.lam[j], h[1], b2); h[3] = cfma(W.lam[j], h[2], b3);
}

struct Ctx { LAS unsigned char* lds; int tid, lane, wave, G, blk; };

constexpr int I_IN = 32 * 288, I_BA = 32, I_GLU = 16 * 32, I_AB = 16 * 64, I_OUT = 32 * 64, I_GU = 32 * 176, I_DN = 88 * 64, I_PL = 4 * 64;
constexpr int CV_EARLY = I_IN + I_BA + I_GLU + 2 * I_AB + I_OUT, CV_ALL = CV_EARLY + I_OUT + 2 * I_GU + I_DN + I_PL;
constexpr int P1_GEMM_WGS = 222;
__device__ __forceinline__ void conv_range(const Args& a, const Ctx& c, int lo, int hi, int gw, int NGW) {
    unsigned char* ws = a.ws;
    LAS float* scr = (LAS float*)(c.lds + c.wave * 16384);
    for (int it = lo + gw; it < hi; it += NGW) {
        int r = it;
        if (r < I_IN) { const int kb = r / 288, nb = r % 288, r0 = 32 * nb, c0 = r0 + (r0 >= 5120 ? 16 : 0); tr_item(a.in[I_WIN], NIN, c0, 64 * kb, (bf16*)(ws + WS_WIN), DM, r0, 32, scr, c.lane); continue; } r -= I_IN;
        if (r < I_BA) { tr_item(a.in[I_WIN], NIN, 5120, 64 * r, (bf16*)(ws + WS_WIN), DM, 9216, 16, scr, c.lane); continue; } r -= I_BA;
        if (r < I_GLU) { const int kb = r / 32, nb = r % 32; tr_item(a.in[I_WGLU], 1024, 32 * nb, 64 * kb, (bf16*)(ws + WS_WGLU), 1024, 32 * nb, 32, scr, c.lane); continue; } r -= I_GLU;
        if (r < I_AB) { const int kb = r / 64, nb = r % 64; tr_item(a.in[I_WA], DM, 32 * nb, 64 * kb, (bf16*)(ws + WS_WA), DM, 32 * nb, 32, scr, c.lane); continue; } r -= I_AB;
        if (r < I_AB) { const int kb = r / 64, nb = r % 64; tr_item(a.in[I_WB], DM, 32 * nb, 64 * kb, (bf16*)(ws + WS_WA) + 1024, DM, 32 * nb, 32, scr, c.lane); continue; } r -= I_AB;
        if (r < I_OUT) { const int kb = r / 64, nb = r % 64; tr_item(a.in[I_WOUT], DM, 32 * nb, 64 * kb, (bf16*)(ws + WS_WOUT), DM, 32 * nb, 32, scr, c.lane); continue; } r -= I_OUT;
        if (r < I_OUT) { const int kb = r / 64, nb = r % 64; tr_item(a.in[I_WPG], DM, 32 * nb, 64 * kb, (bf16*)(ws + WS_WPG), DM, 32 * nb, 32, scr, c.lane); continue; } r -= I_OUT;
        if (r < I_GU) { const int kb = r / 176, nb = r % 176; tr_item(a.in[I_WGATE], FF, 32 * nb, 64 * kb, (bf16*)(ws + WS_WGU), DM, 256 * (nb >> 2) + 32 * (nb & 3), 32, scr, c.lane); continue; } r -= I_GU;
        if (r < I_GU) { const int kb = r / 176, nb = r % 176; tr_item(a.in[I_WUP], FF, 32 * nb, 64 * kb, (bf16*)(ws + WS_WGU), DM, 256 * (nb >> 2) + 32 * (nb & 3) + 128, 32, scr, c.lane); continue; } r -= I_GU;
        if (r < I_DN) { const int kb = r / 64, nb = r % 64; tr_item(a.in[I_WDOWN], DM, 32 * nb, 64 * kb, (bf16*)(ws + WS_WDOWN), FF, 32 * nb, 32, scr, c.lane); continue; } r -= I_DN;
        { const int kb = r / 64, nb = r % 64; tr_item(a.in[I_WPLE], DM, 32 * nb, 64 * kb, (bf16*)(ws + WS_WPLE), PLE, 32 * nb, 32, scr, c.lane); }
    }
}
__device__ __forceinline__ void phase0(const Args& a, const Ctx& c) {
    unsigned char* ws = a.ws;
    const int gw = c.blk * 8 + c.wave, NGW = c.G * 8;
    conv_range(a, c, 0, CV_EARLY, gw, NGW);
    bf16* HB = (bf16*)(ws + WS_HB);
    for (int m = gw; m < TT; m += NGW) {
        const float* xr = (m < TP) ? a.in[I_XP] + (size_t)m * DM : a.in[I_XS] + (size_t)(m - TP) * DM;
        f32x4 v[8]; float s = 0.f;
#pragma unroll
        for (int j = 0; j < 8; ++j) { v[j] = ((const f32x4*)xr)[c.lane + 64 * j]; s += (v[j][0] * v[j][0] + v[j][1] * v[j][1]) + (v[j][2] * v[j][2] + v[j][3] * v[j][3]); }
        const float rs = 1.f / sqrtf(wave_sum(s) * (1.f / DM) + EPS);
#pragma unroll
        for (int j = 0; j < 8; ++j) { const f32x4 gq = ((const f32x4*)a.in[I_GMIX])[c.lane + 64 * j]; const f32x4 o = v[j] * gq * rs;
            u32x2 w; w.x = pk2(o[0], o[1]); w.y = pk2(o[2], o[3]); ((u32x2*)(HB + (size_t)m * DM))[c.lane + 64 * j] = w; }
    }
    bf16* PB = (bf16*)(ws + WS_PB);
    const int gt = c.blk * 512 + c.tid, NGT = c.G * 512;
    for (int i = gt; i < TT * PLE / 4; i += NGT) {
        const int e = i * 4; const f32x4 v = (e < TP * PLE) ? *(const f32x4*)(a.in[I_PP] + e) : *(const f32x4*)(a.in[I_PS] + (e - TP * PLE));
        u32x2 w; w.x = pk2(v[0], v[1]); w.y = pk2(v[2], v[3]); *(u32x2*)(PB + e) = w;
    }
}

constexpr int L_KH = 0, L_QH = 17408, L_VF = 34816, L_LM = 68608, L_GC = 84992, L_BETA = 85248, L_EG = 85504;
__device__ __forceinline__ void dn_precompute(const Args& a, const Ctx& c, int item) {
    const int b = item >> 8, ch = (item >> 3) & 31, h = item & 7;
    const bf16* PROJ = (const bf16*)(a.ws + WS_PROJ);
    const float* BA = (const float*)(a.ws + WS_BA);
    unsigned char* dn = (unsigned char*)a.out + (size_t)item * DN_ITEM;
    const int tok0 = b * SEQ + ch * 64;
    LAS unsigned char* L = c.lds;
    int tid = c.tid; asm volatile("" : "+v"(tid));
    const int l = tid & 63, w = __builtin_amdgcn_readfirstlane(tid >> 6);
    float bl = 0.f, al = 0.f;
    if (w == 0) { bl = BA[(size_t)(tok0 + l) * 16 + h]; al = BA[(size_t)(tok0 + l) * 16 + 8 + h]; }
    {
        float outv[3][8][2];
        unsigned xraw[3][11];
#pragma unroll
        for (int p = 0; p < 3; ++p) {
            const int col = 1024 + p * 1024 + h * 128 + 2 * l;
#pragma unroll
            for (int i = 0; i < 11; ++i) { const int ti = ch * 64 + 8 * w + i - 3;
                xraw[p][i] = 0u; if (ti >= 0) xraw[p][i] = *(const unsigned*)(PROJ + (size_t)(b * SEQ + ti) * NPROJ + col); }
        }
#pragma unroll
        for (int p = 0; p < 3; ++p) {
            f32x2 xr[11], wt[4];
#pragma unroll
            for (int j = 0; j < 4; ++j) wt[j] = *(const f32x2*)(a.in[I_CONVW] + j * CONVC + p * 1024 + h * 128 + 2 * l);
#pragma unroll
            for (int i = 0; i < 11; ++i) xr[i] = (f32x2){bflo(xraw[p][i]), bfhi(xraw[p][i])};
#pragma unroll
            for (int t = 0; t < 8; ++t) { f32x2 s = xr[t] * wt[0] + xr[t + 1] * wt[1] + xr[t + 2] * wt[2] + xr[t + 3] * wt[3];
                outv[p][t][0] = siluf_(s[0]); outv[p][t][1] = siluf_(s[1]); }
        }
#pragma unroll
        for (int t = 0; t < 8; ++t) {
            const float sq = wave_sum(outv[0][t][0] * outv[0][t][0] + outv[0][t][1] * outv[0][t][1]);
            const float sk = wave_sum(outv[1][t][0] * outv[1][t][0] + outv[1][t][1] * outv[1][t][1]);
            const float rq = __builtin_amdgcn_rsqf(sq + EPS) * 0.08838834764831845f, rk = __builtin_amdgcn_rsqf(sk + EPS);
            const int i = 8 * w + t;
            *(LAS unsigned*)(L + L_QH + i * 272 + 4 * l) = pk2(outv[0][t][0] * rq, outv[0][t][1] * rq);
            *(LAS unsigned*)(L + L_KH + i * 272 + 4 * l) = pk2(outv[1][t][0] * rk, outv[1][t][1] * rk);
            *(LAS f32x2*)(L + L_VF + i * 528 + 8 * l) = (f32x2){outv[2][t][0], outv[2][t][1]};
        }
    }
    if (w == 0) {
        const float xx = al + a.in[I_DTB][h];
        const float sp = fmaxf(xx, 0.f) + log1pf(__expf(-fabsf(xx)));
        float g = -__expf(a.in[I_ALOG][h]) * sp;
#pragma unroll
        for (int o = 1; o < 64; o <<= 1) { const float t = __shfl_up(g, o); if (l >= o) g += t; }
        ((LAS float*)(L + L_GC))[l] = g; ((LAS float*)(L + L_BETA))[l] = sigmoidf_(bl); ((LAS float*)(L + L_EG))[l] = __expf(g);
        if (l == 63) ((float*)(a.ws + WS_GL))[item] = __expf(g);
    }
    __syncthreads();
    const LAS float* GC = (const LAS float*)(L + L_GC); const LAS float* BETA = (const LAS float*)(L + L_BETA); const LAS float* EG = (const LAS float*)(L + L_EG);
    {
        const int sel = w >> 2, mt = w & 3, fr = l & 15, fq = l >> 4;
        const LAS unsigned char* Ab = L + (sel ? L_QH : L_KH) + (16 * mt + fr) * 272 + fq * 16;
        bf16x8 af[4];
#pragma unroll
        for (int s = 0; s < 4; ++s) af[s] = *(const LAS bf16x8*)(Ab + s * 64);
#pragma unroll
        for (int nt = 0; nt < 4; ++nt) {
            f32x4 d = (f32x4){0.f, 0.f, 0.f, 0.f};
            const LAS unsigned char* Bb = L + L_KH + (16 * nt + fr) * 272 + fq * 16;
#pragma unroll
            for (int s = 0; s < 4; ++s) d = __builtin_amdgcn_mfma_f32_16x16x32_bf16(af[s], *(const LAS bf16x8*)(Bb + s * 64), d, 0, 0, 0);
            const int j = 16 * nt + fr; const float gj = GC[j];
#pragma unroll
            for (int r = 0; r < 4; ++r) { const int i = 16 * mt + 4 * fq + r; const float dec = __expf(fminf(GC[i] - gj, 0.f));
                if (sel == 0) ((LAS float*)(L + L_LM))[i * 64 + j] = (i > j) ? BETA[i] * d[r] * dec : 0.f;
                else { const float v = (i >= j) ? d[r] * dec : 0.f; ((bf16*)(dn + DN_QK))[i * 64 + permk(j)] = (bf16)(pk2(v, 0.f) & 0xffffu); } }
        }
    }
    __syncthreads();
    if (w < 4) {
        const int col = tid; const bool isu = col < 128; const int cc = col & 127;
        float x[64];
        if (isu) {
            LAS unsigned char* vb = L + L_VF + 4 * cc; asm volatile("" : "+v"(vb));
#pragma unroll
            for (int i = 0; i < 64; ++i) x[i] = *(const LAS float*)(vb + i * 528);
        } else {
            LAS unsigned char* kb = L + L_KH + 2 * cc; asm volatile("" : "+v"(kb));
#pragma unroll
            for (int i = 0; i < 64; ++i) x[i] = bf2f(*(const LAS bf16*)(kb + i * 272));
        }
        {
            LAS unsigned char* bb_ = L + L_BETA; asm volatile("" : "+v"(bb_));
#pragma unroll
            for (int i4 = 0; i4 < 16; ++i4) { const f32x4 bv = *(const LAS f32x4*)(bb_ + 16 * i4); f32x4 ev = *(const LAS f32x4*)(bb_ + 256 + 16 * i4); if (isu) ev = (f32x4){1.f, 1.f, 1.f, 1.f};
#pragma unroll
                for (int jj = 0; jj < 4; ++jj) x[4 * i4 + jj] *= bv[jj] * ev[jj]; }
        }
        asm volatile("" ::: "memory");
        LAS unsigned char* lmb = L + L_LM; asm volatile("" : "+v"(lmb));
        f32x4 lq[2][16];
        lq[1][0] = *(const LAS f32x4*)(lmb + 256);
#pragma unroll
        for (int i = 1; i < 64; ++i) {
            if (i + 1 < 64) {
#pragma unroll
                for (int j4 = 0; j4 < (i + 4) / 4; ++j4) lq[(i + 1) & 1][j4] = *(const LAS f32x4*)(lmb + (i + 1) * 256 + j4 * 16);
            }
            asm volatile("" ::: "memory");
            float r0 = x[i], r1 = 0.f, r2 = 0.f, r3 = 0.f;
#pragma unroll
            for (int j4 = 0; j4 < (i + 3) / 4; ++j4) { const f32x4 lv = lq[i & 1][j4];
                if (4 * j4 + 0 < i) r0 -= lv[0] * x[4 * j4 + 0];
                if (4 * j4 + 1 < i) r1 -= lv[1] * x[4 * j4 + 1];
                if (4 * j4 + 2 < i) r2 -= lv[2] * x[4 * j4 + 2];
                if (4 * j4 + 3 < i) r3 -= lv[3] * x[4 * j4 + 3]; }
            x[i] = (r0 + r1) + (r2 + r3);
        }
        if (isu) {
            const int es = cc >> 4, n = cc & 15;
#pragma unroll
            for (int q = 0; q < 16; ++q) { const int mt = q >> 2, rg = q & 3;
                u32x2 wv; wv.x = pk2(x[4 * q], x[4 * q + 1]); wv.y = pk2(x[4 * q + 2], x[4 * q + 3]);
                *(u32x2*)(dn + DN_U + (size_t)(((es * 4 + mt) * 64 + rg * 16 + n) * 4) * 2) = wv; }
        } else {
            const int pd = permk(cc);
#pragma unroll
            for (int i = 0; i < 64; ++i) ((bf16*)(dn + DN_W))[i * 128 + pd] = (bf16)(pk2(-x[i], 0.f) & 0xffffu);
        }
    } else {
        const int t2 = tid - 256;
        { const int d2 = t2 & 63, i0 = t2 >> 6; const int pd = permk(2 * d2);
#pragma unroll
          for (int k = 0; k < 16; ++k) { const int i = i0 + 4 * k; const unsigned qv = *(const LAS unsigned*)(L + L_QH + i * 272 + 4 * d2); const float e = EG[i];
              *(unsigned*)(dn + DN_QG + (size_t)(i * 128 + pd) * 2) = pk2(bflo(qv) * e, bfhi(qv) * e); } }
        { const int d = t2 & 127, hf = t2 >> 7; const float gl = GC[63];
#pragma unroll
          for (int q = 0; q < 8; ++q) { const int jq = hf * 8 + q;
              const int j0 = 32 * (jq >> 3) + 16 * (jq & 1) + 4 * ((jq >> 1) & 3);
              float kv[4];
#pragma unroll
              for (int r = 0; r < 4; ++r) kv[r] = bf2f(*(const LAS bf16*)(L + L_KH + (j0 + r) * 272 + 2 * d)) * __expf(gl - GC[j0 + r]);
              u32x2 wv; wv.x = pk2(kv[0], kv[1]); wv.y = pk2(kv[2], kv[3]);
              *(u32x2*)(dn + DN_KGT + (size_t)(d * 64 + 4 * jq) * 2) = wv; } }
    }
    __syncthreads();
}

__device__ __forceinline__ void s5_pass1(const Args& a, const Ctx& c, int g, int first, int stride) {
    const bf16* PROJ = (const bf16*)(a.ws + WS_PROJ);
    int l = c.lane; asm volatile("" : "+v"(l));
    const int col = l & 15, rg = l >> 4;
    f32x2 lamS, ccS; s5_state_params(a, g, l, lamS, ccS);
    S5W W; s5_setup(a, g, l, W, lamS, ccS);
    for (int k = first; k < NBP * 31; k += stride) {
        const int b = k / 31, ch = k % 31;
        const int tok0 = b * SEQ + ch * 64;
        u32x4 au[4];
#pragma unroll
        for (int st = 0; st < 4; ++st) au[st] = s5_load_u(PROJ, tok0 + 16 * st, g, 16, l);
        f32x2 hin[4];
#pragma unroll
        for (int j = 0; j < 4; ++j) hin[j] = (f32x2){0.f, 0.f};
#pragma unroll
        for (int st = 0; st < 4; ++st) {
            f32x4 d[8]; s5_bu_tile(au[st], W, d);
#pragma unroll
            for (int j = 0; j < 4; ++j) { f32x2 h[4]; s5_scan_block(W, j, rg, d[j], d[4 + j], hin[j], h); hin[j] = shfl2(h[3], 48 + col); }
        }
        const f32x2 ho = rg == 0 ? hin[0] : rg == 1 ? hin[1] : rg == 2 ? hin[2] : hin[3];
        *(f32x2*)(a.ws + WS_E + ((size_t)((b * NCH + ch) * NG + g) * 64 + l) * 8) = ho;
    }
}

__device__ __forceinline__ void s5_pass2(const Args& a, const Ctx& c, int g, int first, int stride, int vend) {
    const bf16* PROJ = (const bf16*)(a.ws + WS_PROJ);
    bf16* YG = (bf16*)(a.ws + WS_YG);
    LAS unsigned char* hb = c.lds + c.wave * 8192;
    int l = c.lane; asm volatile("" : "+v"(l));
    const int fr = l & 15, fq = l >> 4, col = fr, rg = fq;
    f32x2 lamS, ccS; s5_state_params(a, g, l, lamS, ccS);
    f32x2 pw64 = lamS;
#pragma unroll
    for (int q = 0; q < 6; ++q) pw64 = cmul(pw64, pw64);
    S5W W; s5_setup(a, g, l, W, lamS, ccS);
    bf16x8 cf[4];
#pragma unroll
    for (int s = 0; s < 4; ++s) { const int n0 = 16 * s + 4 * fq;
        const f32x4 vr = *(const f32x4*)(a.in[I_S5CR] + (size_t)(g * 16 + fr) * 64 + n0), vi = *(const f32x4*)(a.in[I_S5CI] + (size_t)(g * 16 + fr) * 64 + n0);
        cf[s] = __builtin_bit_cast(bf16x8, pack8((f32x4){vr[0], -vi[0], vr[1], -vi[1]}, (f32x4){vr[2], -vi[2], vr[3], -vi[3]})); }
    const float dsk = a.in[I_S5D][g * 16 + fr];
    for (int v = first; v < vend; v += stride) {
        const int k = (v & 1) ? 128 + (v >> 1) : (v >> 1);
        const bool prompt = k < 128;
        int tok0, nsub, nvalid, b = 0, ch = 0, sq = 0;
        if (prompt) { ch = k & 31; b = k >> 5; tok0 = b * SEQ + ch * 64; nsub = 4; nvalid = 16; }
        else { sq = k - 128; tok0 = TP + sq * LSM; nsub = 1; nvalid = LSM; }
        u32x4 au[4];
#pragma unroll
        for (int st = 0; st < 4; ++st) { au[st] = (u32x4){0u, 0u, 0u, 0u}; if (st < nsub) au[st] = s5_load_u(PROJ, tok0 + 16 * st, g, nvalid, l); }
        f32x2 hs = (f32x2){0.f, 0.f};
        if (prompt) {
            const f32x2* E = (const f32x2*)(a.ws + WS_E) + ((size_t)(b * NCH) * NG + g) * 64 + l;
            for (int j0 = 0; j0 < ch; j0 += 16) {
                f32x2 ev[16];
#pragma unroll
                for (int j = 0; j < 16; ++j) { ev[j] = (f32x2){0.f, 0.f}; if (j0 + j < ch) ev[j] = E[(size_t)(j0 + j) * NG * 64]; }
#pragma unroll
                for (int j = 0; j < 16; ++j) if (j0 + j < ch) hs = cfma(pw64, hs, ev[j]);
            }
        } else {
            hs = (f32x2){a.in[I_S5RE][(size_t)(sq * NG + g) * 64 + l], a.in[I_S5IM][(size_t)(sq * NG + g) * 64 + l]};
        }
        f32x2 hin[4];
#pragma unroll
        for (int j = 0; j < 4; ++j) hin[j] = shfl2(hs, 16 * j + col);
        const int endsrc = ((nvalid - 1) >> 2) * 16 + col;
#pragma unroll
        for (int st = 0; st < 4; ++st) {
            if (st < nsub) {
            f32x4 d[8]; s5_bu_tile(au[st], W, d);
            if (fq < 2) *(LAS u32x4*)(hb + 4608 + fr * 32 + fq * 16) = au[st];
#pragma unroll
            for (int j = 0; j < 4; ++j) { f32x2 h[4]; s5_scan_block(W, j, rg, d[j], d[4 + j], hin[j], h); hin[j] = shfl2(h[3], endsrc);
#pragma unroll
                for (int i = 0; i < 4; ++i) *(LAS unsigned*)(hb + (4 * rg + i) * 272 + 4 * (16 * j + col)) = pk2(h[i][0], h[i][1]); }
            LDS_WAIT(); asm volatile("" ::: "memory");
            f32x4 y = (f32x4){0.f, 0.f, 0.f, 0.f};
#pragma unroll
            for (int s = 0; s < 4; ++s) y = __builtin_amdgcn_mfma_f32_16x16x32_bf16(*(const LAS bf16x8*)(hb + fr * 272 + s * 64 + fq * 16), cf[s], y, 0, 0, 0);
#pragma unroll
            for (int r = 0; r < 4; ++r) { const int t = 4 * fq + r;
                if (t < nvalid) { const float v = y[r] + dsk * bf2f(*(const LAS bf16*)(hb + 4608 + t * 32 + fr * 2)); YG[(size_t)(tok0 + 16 * st + t) * 1024 + g * 16 + fr] = (bf16)(pk2(gelu_tanh(v), 0.f) & 0xffffu); } }
            LDS_WAIT(); asm volatile("" ::: "memory");
            }
        }
        const f32x2 ho = rg == 0 ? hin[0] : rg == 1 ? hin[1] : rg == 2 ? hin[2] : hin[3];
        if (prompt) { if (ch == 31) { a.out[O_S5RP + (size_t)(b * NG + g) * 64 + l] = ho[0]; a.out[O_S5IP + (size_t)(b * NG + g) * 64 + l] = ho[1]; } }
        else { a.out[O_S5RS + (size_t)(sq * NG + g) * 64 + l] = ho[0]; a.out[O_S5IS + (size_t)(sq * NG + g) * 64 + l] = ho[1]; }
    }
}

constexpr int Q_W = 0, Q_QG = 17408, Q_KGT = 34816, Q_QK = 53248;
__device__ __forceinline__ void dn_sequential(const Args& a, const Ctx& c, int bh) {
    int tid = c.tid; asm volatile("" : "+v"(tid));
    const int b = bh >> 3, h = bh & 7, es = __builtin_amdgcn_readfirstlane(tid >> 6), l = tid & 63, fr = l & 15, fq = l >> 4;
    LAS unsigned char* L = c.lds;
    float* O = (float*)(a.ws + WS_O);
    const float* GL = (const float*)(a.ws + WS_GL);
    f32x4 S[8];
#pragma unroll
    for (int i = 0; i < 8; ++i) S[i] = (f32x4){0.f, 0.f, 0.f, 0.f};
    constexpr int QBUF = 62464;
    u32x4 pw[2], pq[2], pk_[2], pqk; u32x2 uu[4]; float gl;
#define DNQ_LOAD(chn) do { const int item_ = (b * NCH + (chn)) * NH + h; const unsigned char* dn_ = (const unsigned char*)a.out + (size_t)item_ * DN_ITEM; \
        _Pragma("unroll") for (int q = 0; q < 2; ++q) { const int p = tid + 512 * q; pw[q] = *(const u32x4*)(dn_ + DN_W + (size_t)p * 16); pq[q] = *(const u32x4*)(dn_ + DN_QG + (size_t)p * 16); pk_[q] = *(const u32x4*)(dn_ + DN_KGT + (size_t)p * 16); } \
        pqk = *(const u32x4*)(dn_ + DN_QK + (size_t)tid * 16); \
        _Pragma("unroll") for (int mt = 0; mt < 4; ++mt) uu[mt] = *(const u32x2*)(dn_ + DN_U + (size_t)(((es * 4 + mt) * 64 + l) * 4) * 2); \
        gl = GL[item_]; } while (0)
#define DNQ_STORE(Lb) do { \
        _Pragma("unroll") for (int q = 0; q < 2; ++q) { const int p = tid + 512 * q; *(LAS u32x4*)((Lb) + Q_W + (p >> 4) * 272 + (p & 15) * 16) = pw[q]; *(LAS u32x4*)((Lb) + Q_QG + (p >> 4) * 272 + (p & 15) * 16) = pq[q]; \
            *(LAS u32x4*)((Lb) + Q_KGT + (p >> 3) * 144 + (p & 7) * 16) = pk_[q]; } \
        *(LAS u32x4*)((Lb) + Q_QK + (tid >> 3) * 144 + (tid & 7) * 16) = pqk; } while (0)
    DNQ_LOAD(0);
    DNQ_STORE(L);
    __syncthreads();
    for (int ch = 0; ch < NCH; ++ch) {
        LAS unsigned char* Lc = L + (ch & 1) * QBUF;
        const u32x2 uc0 = uu[0], uc1 = uu[1], uc2 = uu[2], uc3 = uu[3]; const float glc = gl;
        if (ch + 1 < NCH) DNQ_LOAD(ch + 1);
        bf16x8 Sb[4];
#pragma unroll
        for (int s = 0; s < 4; ++s) Sb[s] = __builtin_bit_cast(bf16x8, pack8(S[2 * s], S[2 * s + 1]));
        f32x4 vn[4];
#pragma unroll
        for (int mt = 0; mt < 4; ++mt) {
            const u32x2 ucm = mt == 0 ? uc0 : mt == 1 ? uc1 : mt == 2 ? uc2 : uc3;
            f32x4 acc = (f32x4){bflo(ucm.x), bfhi(ucm.x), bflo(ucm.y), bfhi(ucm.y)};
#pragma unroll
            for (int s = 0; s < 4; ++s) acc = __builtin_amdgcn_mfma_f32_16x16x32_bf16(*(const LAS bf16x8*)(Lc + Q_W + (16 * mt + fr) * 272 + s * 64 + fq * 16), Sb[s], acc, 0, 0, 0);
            vn[mt] = acc;
        }
        bf16x8 vb[2];
        vb[0] = __builtin_bit_cast(bf16x8, pack8(vn[0], vn[1])); vb[1] = __builtin_bit_cast(bf16x8, pack8(vn[2], vn[3]));
#pragma unroll
        for (int mt = 0; mt < 4; ++mt) {
            f32x4 acc = (f32x4){0.f, 0.f, 0.f, 0.f};
#pragma unroll
            for (int s = 0; s < 4; ++s) acc = __builtin_amdgcn_mfma_f32_16x16x32_bf16(*(const LAS bf16x8*)(Lc + Q_QG + (16 * mt + fr) * 272 + s * 64 + fq * 16), Sb[s], acc, 0, 0, 0);
#pragma unroll
            for (int s = 0; s < 2; ++s) acc = __builtin_amdgcn_mfma_f32_16x16x32_bf16(*(const LAS bf16x8*)(Lc + Q_QK + (16 * mt + fr) * 144 + s * 64 + fq * 16), vb[s], acc, 0, 0, 0);
            const int tok = b * SEQ + ch * 64 + 16 * mt + 4 * fq;
#pragma unroll
            for (int r = 0; r < 4; ++r) O[(size_t)(tok + r) * 1024 + h * 128 + es * 16 + fr] = acc[r];
        }
#pragma unroll
        for (int dt = 0; dt < 8; ++dt) {
            f32x4 acc = S[dt] * glc;
#pragma unroll
            for (int s = 0; s < 2; ++s) acc = __builtin_amdgcn_mfma_f32_16x16x32_bf16(*(const LAS bf16x8*)(Lc + Q_KGT + (16 * dt + fr) * 144 + s * 64 + fq * 16), vb[s], acc, 0, 0, 0);
            S[dt] = acc;
        }
        if (ch + 1 < NCH) DNQ_STORE(L + ((ch + 1) & 1) * QBUF);
        __syncthreads();
    }
#undef DNQ_LOAD
#undef DNQ_STORE
    float* SO = a.out + O_DELTAP + (size_t)(b * NH + h) * HD * HD;
#pragma unroll
    for (int dt = 0; dt < 8; ++dt)
#pragma unroll
        for (int r = 0; r < 4; ++r) SO[(size_t)(16 * dt + 4 * fq + r) * HD + es * 16 + fr] = S[dt][r];
}

__device__ __forceinline__ void dn_sample(const Args& a, const Ctx& c, int item, bool valid) {
    int tid = c.tid; asm volatile("" : "+v"(tid));
    const int wave = __builtin_amdgcn_readfirstlane(tid >> 6), lane = tid & 63;
    const int il = wave >> 1, e = tid & 127, wv = wave & 1;
    const int sq = item >> 3, h = item & 7;
    const bf16* PROJ = (const bf16*)(a.ws + WS_PROJ);
    const float* BA = (const float*)(a.ws + WS_BA);
    LAS float* QS = (LAS float*)(c.lds + il * 8192);
    LAS float* KS = (LAS float*)(c.lds + il * 8192 + 4096);
    LAS float* RED = (LAS float*)(c.lds + 32768 + il * 256);
    float qv[8], kv[8], vv[8];
    float S[128];
    if (valid) {
#pragma unroll
        for (int p = 0; p < 3; ++p) {
            const int cch = p * 1024 + h * 128 + e;
            float wt[4];
#pragma unroll
            for (int j = 0; j < 4; ++j) wt[j] = a.in[I_CONVW][j * CONVC + cch];
            float xr[11];
#pragma unroll
            for (int i = 0; i < 3; ++i) xr[i] = a.in[I_SCONV][(size_t)(sq * 3 + i) * CONVC + cch];
#pragma unroll
            for (int i = 0; i < 8; ++i) xr[3 + i] = bf2f(PROJ[(size_t)(TP + sq * LSM + i) * NPROJ + 1024 + cch]);
#pragma unroll
            for (int t = 0; t < 8; ++t) { const float s = siluf_(xr[t] * wt[0] + xr[t + 1] * wt[1] + xr[t + 2] * wt[2] + xr[t + 3] * wt[3]);
                if (p == 0) qv[t] = s; else if (p == 1) kv[t] = s; else vv[t] = s; }
        }
#pragma unroll
        for (int t = 0; t < 8; ++t) { const float s1 = wave_sum(qv[t] * qv[t]), s2 = wave_sum(kv[t] * kv[t]); if (lane == 0) { RED[wv * 16 + t] = s1; RED[wv * 16 + 8 + t] = s2; } }
    }
    __syncthreads();
    if (valid) {
#pragma unroll
        for (int t = 0; t < 8; ++t) { const float sq_ = RED[t] + RED[16 + t], sk_ = RED[8 + t] + RED[24 + t];
            QS[t * 128 + e] = qv[t] * __builtin_amdgcn_rsqf(sq_ + EPS) * 0.08838834764831845f; KS[t * 128 + e] = kv[t] * __builtin_amdgcn_rsqf(sk_ + EPS); }
    }
    __syncthreads();
    if (valid) {
        { const float* S0 = a.in[I_SDELTA] + (size_t)item * HD * HD + e;
#pragma unroll
          for (int d = 0; d < 128; ++d) S[d] = __builtin_nontemporal_load(S0 + (size_t)d * HD); }
        float* O = (float*)(a.ws + WS_O);
        const float alog = __expf(a.in[I_ALOG][h]), dtb = a.in[I_DTB][h];
        for (int t = 0; t < 8; ++t) {
            const int tok = TP + sq * LSM + t;
            const float beta = sigmoidf_(BA[(size_t)tok * 16 + h]); const float xx = BA[(size_t)tok * 16 + 8 + h] + dtb;
            const float aa = __expf(-alog * (fmaxf(xx, 0.f) + log1pf(__expf(-fabsf(xx)))));
            const LAS f32x4* kq = (const LAS f32x4*)(KS + t * 128); const LAS f32x4* qq = (const LAS f32x4*)(QS + t * 128);
            float ks0 = 0.f, ks1 = 0.f, ks2 = 0.f, ks3 = 0.f;
#pragma unroll
            for (int d8 = 0; d8 < 4; ++d8) {
#pragma unroll
                for (int dd = 0; dd < 8; ++dd) { const int d4 = 8 * d8 + dd; const f32x4 k4 = kq[d4]; ks0 += S[4 * d4] * k4[0]; ks1 += S[4 * d4 + 1] * k4[1]; ks2 += S[4 * d4 + 2] * k4[2]; ks3 += S[4 * d4 + 3] * k4[3]; }
                asm volatile("" ::: "memory"); }
            const float vnew = beta * (vv[t] - aa * ((ks0 + ks1) + (ks2 + ks3)));
            float o0 = 0.f, o1 = 0.f, o2 = 0.f, o3 = 0.f;
#pragma unroll
            for (int d8 = 0; d8 < 8; ++d8) {
#pragma unroll
                for (int dd = 0; dd < 4; ++dd) { const int d4 = 4 * d8 + dd; const f32x4 k4 = kq[d4], q4 = qq[d4];
                    float sn;
                    sn = aa * S[4 * d4 + 0] + k4[0] * vnew; S[4 * d4 + 0] = sn; o0 += sn * q4[0];
                    sn = aa * S[4 * d4 + 1] + k4[1] * vnew; S[4 * d4 + 1] = sn; o1 += sn * q4[1];
                    sn = aa * S[4 * d4 + 2] + k4[2] * vnew; S[4 * d4 + 2] = sn; o2 += sn * q4[2];
                    sn = aa * S[4 * d4 + 3] + k4[3] * vnew; S[4 * d4 + 3] = sn; o3 += sn * q4[3]; }
                asm volatile("" ::: "memory"); }
            const float o = (o0 + o1) + (o2 + o3);
            O[(size_t)tok * 1024 + h * 128 + e] = o;
        }
        float* SO = a.out + O_DELTAS + (size_t)item * HD * HD + e;
#pragma unroll
        for (int d = 0; d < 128; ++d) __builtin_nontemporal_store(S[d], SO + (size_t)d * HD);
    }
    __syncthreads();
}

__device__ __forceinline__ void reduce_sample_rows(const Ctx& c, const float* base, const float* slab, float* XO, bf16* XG, const float* gw, float* ssq) {
    for (int r = c.blk * 8 + c.wave; r < TS; r += c.G * 8) {
        float s = 0.f;
#pragma unroll 2
        for (int j = 0; j < 8; ++j) { const int col = 4 * (c.lane + 64 * j);
            f32x4 v = *(const f32x4*)(base + (size_t)r * DM + col);
#pragma unroll
            for (int kc = 0; kc < 8; ++kc) v += *(const f32x4*)(slab + ((size_t)kc * TS + r) * DM + col);
            *(f32x4*)(XO + (size_t)r * DM + col) = v;
            const f32x4 gq = *(const f32x4*)(gw + col); const f32x4 o = v * gq;
            u32x2 w; w.x = pk2(o[0], o[1]); w.y = pk2(o[2], o[3]); *(u32x2*)(XG + (size_t)r * DM + col) = w;
            s += (v[0] * v[0] + v[1] * v[1]) + (v[2] * v[2] + v[3] * v[3]); }
        s = wave_sum(s); if (c.lane == 0) ssq[r] = s;
    }
}

__global__ void __launch_bounds__(512, 2) fwd_megakernel(Args args) {
    extern __shared__ __attribute__((aligned(16))) unsigned char lds_raw[];
    Ctx c; c.lds = (LAS unsigned char*)lds_raw; c.tid = threadIdx.x; c.lane = c.tid & 63; c.wave = __builtin_amdgcn_readfirstlane(c.tid >> 6); c.G = gridDim.x; c.blk = blockIdx.x;
    volatile LAS unsigned* MISC = (volatile LAS unsigned*)(c.lds + MISC_OFF);
    unsigned char* ws = args.ws;
    unsigned* ctl = (unsigned*)(ws + WS_CTL);
    for (int u = c.tid; u < (LDS_BYTES - RING_BYTES) / 4; u += 512) ((LAS unsigned*)(c.lds + RING_BYTES))[u] = 0u;
    __syncthreads();
    XcdBarrier bar; bar.bar = ctl + CW_BAR; bar.x = 0; bar.st = nullptr;
    if (MK_N_LAUNCHES == 1) bar = xcd_barrier_post(ctl + CW_BAR, MISC + 8);
    const int lo = args.ph_lo, hi = args.ph_hi;
#ifndef PH_MASK
#define PH_MASK 0x1fff
#endif
#define IN(k) (((PH_MASK >> (k)) & 1) && lo <= (k) && (k) < hi)
#ifndef REP_MASK
#define REP_MASK 0
#endif
#define PHASE(k) for (int rep_ = 0; IN(k) && rep_ <= ((REP_MASK >> (k)) & 1); ++rep_)
#define REPSYNC() do { if (rep_) xcd_barrier(bar); } while (0)
#define SEAM(k) do { if (IN(k) && IN((k) + 1)) xcd_barrier(bar); } while (0)
    bf16* PROJ = (bf16*)(ws + WS_PROJ);
    float* ssq1 = (float*)(ctl + CW_SSQ1); float* ssq2 = (float*)(ctl + CW_SSQ2); float* ssq3 = (float*)(ctl + CW_SSQ3);
    float* Y = args.out + O_Y;

    PHASE(0) { REPSYNC(); phase0(args, c); } SEAM(0);
    PHASE(1) { REPSYNC();
        if (c.blk < P1_GEMM_WGS) {
            pg8::Gemm g{(const bf16*)(ws + WS_HB), (const bf16*)(ws + WS_WIN), TT, NINP, DM}; pg8::StaticOrder S; S.init(TT, NINP, P1_GEMM_WGS, c.blk);
            EpiProj E{PROJ, (float*)(ws + WS_BA)};
            pg8::gemm_phase<EpiProj, pg8::StaticOrder>(c.lds, g, S, E);
        } else conv_range(args, c, CV_EARLY, CV_ALL, (c.blk - P1_GEMM_WGS) * 8 + c.wave, (c.G - P1_GEMM_WGS) * 8);
    } SEAM(1);
    PHASE(2) { REPSYNC();
#ifndef REPX
#define REPX 0
#endif
        for (int rx = 0; rx <= ((REPX >> 0) & 1); ++rx)
        for (int it = c.blk; it < NBP * NCH * NH; it += c.G) dn_precompute(args, c, it);
        __syncthreads();
        for (int rx = 0; rx <= ((REPX >> 1) & 1); ++rx)
        { const int wi = c.blk * 8 + c.wave; s5_pass1(args, c, wi & 63, wi >> 6, (c.G * 8) >> 6); }
        for (int i = c.blk * 512 + c.tid; i < (NBP + NSB) * 3 * CONVC; i += c.G * 512) {
            const int cc = i % CONVC, rr = (i / CONVC) % 3, sq = i / (3 * CONVC);
            if (sq < NBP) args.out[O_CONVP + (size_t)(sq * 3 + rr) * CONVC + cc] = bf2f(PROJ[(size_t)(sq * SEQ + SEQ - 3 + rr) * NPROJ + 1024 + cc]);
            else { const int s2 = sq - NBP; args.out[O_CONVS + (size_t)(s2 * 3 + rr) * CONVC + cc] = bf2f(PROJ[(size_t)(TP + s2 * LSM + LSM - 3 + rr) * NPROJ + 1024 + cc]); }
        }
    } SEAM(2);
    PHASE(3) { REPSYNC();
        if (c.blk < 32) { for (int rx = 0; rx <= ((REPX >> 2) & 1); ++rx) dn_sequential(args, c, c.blk); }
        else {
            const int nb = c.G - 32, rb = c.blk - 32;
            for (int rx = 0; rx <= ((REPX >> 3) & 1); ++rx) {
                { const int it = rb * 4 + (c.wave >> 1); dn_sample(args, c, it, true); }
                if (rb < 32) { const int it = nb * 4 + rb * 4 + (c.wave >> 1); dn_sample(args, c, it, it < NSB * NH); }
            }
            __syncthreads();
            for (int rx = 0; rx <= ((REPX >> 4) & 1); ++rx)
            { const int wi = rb * 8 + c.wave, slot = wi >> 6;
              if (slot < 4) s5_pass2(args, c, wi & 63, slot, 4, 8); else s5_pass2(args, c, wi & 63, 8 + slot - 4, 24, 256); }
        }
    } SEAM(3);
    PHASE(4) { REPSYNC();
        if (c.blk < 144) {
            pg8::Gemm g{(const bf16*)(ws + WS_YG), (const bf16*)(ws + WS_WGLU), TT, 1024, 1024}; pg8::StaticOrder S; S.init(TT, 1024, 144, c.blk);
            EpiGlu E{(const bf16*)(ws + WS_YG), (bf16*)(ws + WS_YCAT), args.in[I_BGLU]};
            pg8::gemm_phase<EpiGlu, pg8::StaticOrder>(c.lds, g, S, E);
        } else {
            const float* O = (const float*)(ws + WS_O); bf16* YDN = (bf16*)(ws + WS_YCAT) + 1024;
            const f32x2 ow = *(const f32x2*)(args.in[I_ONORM] + 2 * c.lane);
            for (int tok = (c.blk - 144) * 8 + c.wave; tok < TT; tok += (c.G - 144) * 8) {
                const float* orow = O + (size_t)tok * 1024 + 2 * c.lane; const bf16* zrow = PROJ + (size_t)tok * NPROJ + 4096 + 2 * c.lane; bf16* yrow = YDN + (size_t)tok * DM + 2 * c.lane;
                f32x2 o[8]; unsigned zz[8];
#pragma unroll
                for (int h = 0; h < 8; ++h) { o[h] = *(const f32x2*)(orow + h * 128); zz[h] = *(const unsigned*)(zrow + h * 128); }
#pragma unroll
                for (int h = 0; h < 8; ++h) {
                    const float rs = __builtin_amdgcn_rsqf(wave_sum(o[h][0] * o[h][0] + o[h][1] * o[h][1]) * (1.f / HD) + EPS);
                    *(unsigned*)(yrow + h * 128) = pk2(o[h][0] * rs * ow[0] * siluf_(bflo(zz[h])), o[h][1] * rs * ow[1] * siluf_(bfhi(zz[h])));
                }
            }
        }
    } SEAM(4);
    PHASE(5) { REPSYNC();
        pg8::Gemm g{(const bf16*)(ws + WS_YCAT), (const bf16*)(ws + WS_WA), TT, DM, DM, 0}; pg8::StaticOrder S; S.init(TT, DM, c.G, c.blk);
        EpiMix E{PROJ, (bf16*)(ws + WS_MIX)}; pg8::gemm_phase<EpiMix, pg8::StaticOrder>(c.lds, g, S, E);
    } SEAM(5);
    PHASE(6) { REPSYNC();
        { pg8::Gemm g{(const bf16*)(ws + WS_MIX), (const bf16*)(ws + WS_WOUT), TP, DM, DM, 0}; pg8::StaticOrder S; S.init(TP, DM, c.G, c.blk);
          EpiResid E{args.in[I_XP], args.in[I_XS], (float*)(ws + WS_X1), (bf16*)(ws + WS_X1G), args.in[I_GFFN], ssq1};
          pg8::gemm_phase<EpiResid, pg8::StaticOrder>(c.lds, g, S, E); }
        { const int kc = c.blk & 7;
          pg8::Gemm g{(const bf16*)(ws + WS_MIX) + kc * 256, (const bf16*)(ws + WS_WOUT) + kc * 256, TT, DM, 256, DM}; TailOrder S{c.blk};
          EpiSlab E{Y + (size_t)kc * TS * DM};
          pg8::gemm_phase<EpiSlab, TailOrder>(c.lds, g, S, E); }
    } SEAM(6);
    PHASE(7) { REPSYNC();
        reduce_sample_rows(c, args.in[I_XS], Y, (float*)(ws + WS_X1) + (size_t)TP * DM, (bf16*)(ws + WS_X1G) + (size_t)TP * DM, args.in[I_GFFN], ssq1 + TP);
    } SEAM(7);
    PHASE(8) { REPSYNC();
        pg8::Gemm g{(const bf16*)(ws + WS_X1G), (const bf16*)(ws + WS_WGU), TT, 2 * FF, DM}; pg8::StaticOrder S; S.init(TT, 2 * FF, c.G, c.blk);
        EpiGU E{ssq1, (bf16*)(ws + WS_ACT)};
        pg8::gemm_phase<EpiGU, pg8::StaticOrder>(c.lds, g, S, E);
    } SEAM(8);
    PHASE(9) { REPSYNC();
        const float* x1 = (const float*)(ws + WS_X1);
        { pg8::Gemm g{(const bf16*)(ws + WS_ACT), (const bf16*)(ws + WS_WDOWN), TP, DM, FF, 0}; pg8::StaticOrder S; S.init(TP, DM, c.G, c.blk);
          EpiResid E{x1, x1 + (size_t)TP * DM, Y, (bf16*)(ws + WS_X2G), args.in[I_GPLE], ssq2};
          pg8::gemm_phase<EpiResid, pg8::StaticOrder>(c.lds, g, S, E); }
        { const int kc = c.blk & 7, kt0 = (kc >> 1) * 22 + (kc & 1) * 12, nkt = (kc & 1) ? 10 : 12;
          pg8::Gemm g{(const bf16*)(ws + WS_ACT) + kt0 * 64, (const bf16*)(ws + WS_WDOWN) + kt0 * 64, TT, DM, nkt * 64, FF}; TailOrder S{c.blk};
          EpiSlab E{(float*)(ws + WS_SLAB) + (size_t)kc * TS * DM};
          pg8::gemm_phase<EpiSlab, TailOrder>(c.lds, g, S, E); }
    } SEAM(9);
    PHASE(10) { REPSYNC();
        reduce_sample_rows(c, (const float*)(ws + WS_X1) + (size_t)TP * DM, (const float*)(ws + WS_SLAB), Y + (size_t)TP * DM, (bf16*)(ws + WS_X2G) + (size_t)TP * DM, args.in[I_GPLE], ssq2 + TP);
        { pg8::Gemm g{(const bf16*)(ws + WS_PB), (const bf16*)(ws + WS_WPLE), TT, DM, PLE, 0}; pg8::StaticOrder S; S.init(TT, DM, c.G, c.blk);
          EpiF32 E{(float*)(ws + WS_TPLE)}; pg8::gemm_phase<EpiF32, pg8::StaticOrder>(c.lds, g, S, E); }
    } SEAM(10);
    PHASE(11) { REPSYNC();
        { pg8::Gemm g{(const bf16*)(ws + WS_X2G), (const bf16*)(ws + WS_WPG), TP, DM, DM, 0}; pg8::StaticOrder S; S.init(TP, DM, c.G, c.blk);
          EpiPleB E{Y, (const float*)(ws + WS_TPLE), ssq2, ssq3}; pg8::gemm_phase<EpiPleB, pg8::StaticOrder>(c.lds, g, S, E); }
        { const int kc = c.blk & 7;
          pg8::Gemm g{(const bf16*)(ws + WS_X2G) + kc * 256, (const bf16*)(ws + WS_WPG) + kc * 256, TT, DM, 256, DM}; TailOrder S{c.blk};
          EpiSlab E{(float*)(ws + WS_SLAB) + (size_t)kc * TS * DM};
          pg8::gemm_phase<EpiSlab, TailOrder>(c.lds, g, S, E); }
    } SEAM(11);
    PHASE(12) { REPSYNC();
        for (int m = c.blk * 8 + c.wave; m < TT; m += c.G * 8) {
            f32x4* yr = (f32x4*)(Y + (size_t)m * DM);
            if (m < TP) {
                const float rs = 1.f / sqrtf(ssq3[m] * (1.f / DM) + EPS);
#pragma unroll
                for (int j = 0; j < 8; ++j) { const f32x4 gq = ((const f32x4*)args.in[I_GFIN])[c.lane + 64 * j]; __builtin_nontemporal_store(yr[c.lane + 64 * j] * gq * rs, yr + c.lane + 64 * j); }
            } else {
                const int r = m - TP; const float rs2 = __builtin_amdgcn_rsqf(ssq2[m] * (1.f / DM) + EPS);
                const f32x4* tp = (const f32x4*)((const float*)(ws + WS_TPLE) + (size_t)m * DM);
                f32x4 x3[8]; float sq = 0.f;
#pragma unroll
                for (int j = 0; j < 8; ++j) { const int q = c.lane + 64 * j;
                    f32x4 v = (f32x4){0.f, 0.f, 0.f, 0.f};
#pragma unroll
                    for (int kc = 0; kc < 8; ++kc) v += ((const f32x4*)((const float*)(ws + WS_SLAB) + ((size_t)kc * TS + r) * DM))[q];
                    x3[j] = yr[q] + tp[q] * sig4(v * rs2);
                    sq += (x3[j][0] * x3[j][0] + x3[j][1] * x3[j][1]) + (x3[j][2] * x3[j][2] + x3[j][3] * x3[j][3]); }
                const float rs = 1.f / sqrtf(wave_sum(sq) * (1.f / DM) + EPS);
#pragma unroll
                for (int j = 0; j < 8; ++j) { const f32x4 gq = ((const f32x4*)args.in[I_GFIN])[c.lane + 64 * j]; __builtin_nontemporal_store(x3[j] * gq * rs, yr + c.lane + 64 * j); }
            }
        }
    }
#undef IN
#undef SEAM
}

extern "C" void kernel_launch(void* const* d_in, const int* in_sizes, int n_in, void* d_out, int out_size, void* d_ws, size_t ws_size, hipStream_t stream) {
    static int grid = 0;
    if (grid == 0) {
        if (n_in != 35 || out_size != (int)O_END || ws_size < WS_END) { fprintf(stderr, "kernel_launch: unexpected problem (n_in %d out %d ws %zu)\n", n_in, out_size, ws_size); grid = -1; return; }
        int dev = 0, cus = 0, per_cu = 0;
        if (hipGetDevice(&dev) != hipSuccess || hipDeviceGetAttribute(&cus, hipDeviceAttributeMultiprocessorCount, dev) != hipSuccess) { grid = -1; return; }
        if (hipFuncSetAttribute((const void*)fwd_megakernel, hipFuncAttributeMaxDynamicSharedMemorySize, LDS_BYTES) != hipSuccess) { fprintf(stderr, "kernel_launch: hipFuncSetAttribute failed\n"); grid = -1; return; }
        if (hipOccupancyMaxActiveBlocksPerMultiprocessor(&per_cu, (const void*)fwd_megakernel, 512, LDS_BYTES) != hipSuccess || per_cu < 1) { fprintf(stderr, "kernel_launch: occupancy query reports %d\n", per_cu); (void)hipGetLastError(); grid = -1; return; }
        grid = cus;
        if (grid != 256) { fprintf(stderr, "kernel_launch: unsupported CU count %d\n", cus); grid = -1; return; }
    }
    if (grid < 0) return;
    (void)hipMemsetAsync((char*)d_ws + WS_CTL, 0, CTL_ZERO_BYTES, stream);
    Args a{};
    for (int i = 0; i < 35; ++i) a.in[i] = (const float*)d_in[i];
    a.out = (float*)d_out; a.ws = (unsigned char*)d_ws;
    if (MK_N_LAUNCHES == 1) {
        a.ph_lo = 0; a.ph_hi = 13; a.li = 0;
        void* kargs[] = {&a};
        hipError_t e = hipLaunchCooperativeKernel((const void*)fwd_megakernel, dim3(grid), dim3(512), kargs, LDS_BYTES, stream);
        if (e != hipSuccess) fprintf(stderr, "kernel_launch: cooperative launch failed: %s\n", hipGetErrorString(e));
    } else {
        for (int p = 0; p < 13; ++p) { a.ph_lo = p; a.ph_hi = p + 1; a.li = p; hipLaunchKernelGGL(fwd_megakernel, dim3(grid), dim3(512), LDS_BYTES, stream, a); }
    }
}
```

```cpp
#include <hip/hip_runtime.h>
#include <cstdio>
#include <cstdint>

#ifndef MK_N_LAUNCHES
#define MK_N_LAUNCHES 1
#endif

#define LAS __attribute__((address_space(3)))
typedef unsigned short bf16;
typedef short bf16x8 __attribute__((ext_vector_type(8)));
typedef float f32x4 __attribute__((ext_vector_type(4)));
typedef float f32x2 __attribute__((ext_vector_type(2)));
typedef unsigned u32x4 __attribute__((ext_vector_type(4)));
typedef unsigned u32x2 __attribute__((ext_vector_type(2)));
typedef __bf16 bf2_t __attribute__((ext_vector_type(2)));

constexpr int DM = 2048, TP = 8192, TS = 1024, TT = 9216, SEQ = 2048, NBP = 4, NSB = 128, LSM = 8;
constexpr int NIN = 9232, NPROJ = 9216, NINP = 9472, FF = 5632, PLE = 256;
constexpr int NG = 64, NH = 8, HD = 128, CONVC = 3072, NCH = 32;
constexpr float EPS = 1e-6f;

constexpr size_t MiB = 1u << 20;
constexpr size_t WS_CTL = 0, CTL_ZERO_BYTES = 1 * MiB;
constexpr size_t WS_WIN = 1 * MiB, WS_WGLU = 38 * MiB, WS_WA = 40 * MiB, WS_WB = 44 * MiB, WS_WOUT = 48 * MiB, WS_WGU = 56 * MiB, WS_WDOWN = 100 * MiB, WS_WPLE = 122 * MiB, WS_WPG = 123 * MiB;
constexpr size_t WS_BA = 131 * MiB, WS_GL = 131 * MiB + 768 * 1024, WS_PB = 132 * MiB, WS_E = 137 * MiB;
constexpr size_t WS_HB = 141 * MiB, WS_YG = 141 * MiB, WS_YS = 159 * MiB, WS_X2G = 141 * MiB;
constexpr size_t WS_PROJ = 177 * MiB, WS_X1 = 177 * MiB, WS_X1G = 249 * MiB, WS_ACT = 285 * MiB, WS_TPLE = 285 * MiB;
constexpr size_t WS_YCAT = 1 * MiB;
constexpr size_t WS_SLAB = 1 * MiB;
constexpr size_t WS_O = 339 * MiB, WS_MIX = 339 * MiB, WS_YDN = 375 * MiB, WS_END = 393 * MiB;
constexpr int CW_BAR = 4096;
constexpr int CW_SSQ1 = 65536, CW_SSQ2 = 81920, CW_SSQ3 = 98304;
constexpr size_t O_Y = 0, O_CONVP = 18874368, O_DELTAP = 18911232, O_S5RP = 19435520, O_S5IP = 19451904, O_CONVS = 19468288, O_DELTAS = 20647936, O_S5RS = 37425152, O_S5IS = 37949440, O_END = 38473728;
constexpr size_t DN_ITEM = 73728, DN_W = 0, DN_QG = 16384, DN_KGT = 32768, DN_QK = 49152, DN_U = 57344;

constexpr int RING_BYTES = 131072, MISC_OFF = RING_BYTES + 320, LDS_BYTES = 147456;

__device__ __forceinline__ unsigned pk2(float a, float b) { bf2_t v; v.x = (__bf16)a; v.y = (__bf16)b; return __builtin_bit_cast(unsigned, v); }
__device__ __forceinline__ float bflo(unsigned w) { return __builtin_bit_cast(float, w << 16); }
__device__ __forceinline__ float bfhi(unsigned w) { return __builtin_bit_cast(float, w & 0xffff0000u); }
__device__ __forceinline__ float bf2f(bf16 h) { return __builtin_bit_cast(float, (unsigned)h << 16); }
__device__ __forceinline__ f32x4 ldnt4(const float* p) { return __builtin_nontemporal_load((const f32x4*)p); }
__device__ __forceinline__ float sigmoidf_(float x) { return 1.f / (1.f + __expf(-x)); }
__device__ __forceinline__ float siluf_(float x) { return x / (1.f + __expf(-x)); }
__device__ __forceinline__ float gelu_tanh(float x) { const float z = 0.7978845608028654f * (x + 0.044715f * x * x * x); return x * __builtin_amdgcn_rcpf(1.f + __expf(-2.f * z)); }
__device__ __forceinline__ int permk(int x) { return (x & ~31) | (8 * ((x >> 2) & 3) + 4 * ((x >> 4) & 1) + (x & 3)); }
#define LDS_WAIT() asm volatile("s_waitcnt lgkmcnt(0)" ::: "memory")

struct Args {
    const float* in[35]; float* out; unsigned char* ws; int ph_lo, ph_hi, li, pad;
};
enum { I_XP = 0, I_XS, I_SCONV, I_SDELTA, I_S5RE, I_S5IM, I_PP, I_PS, I_GMIX, I_WIN, I_CONVW, I_ALOG, I_DTB, I_ONORM, I_S5AR, I_S5AI, I_S5BR, I_S5BI, I_S5CR, I_S5CI, I_S5D, I_S5LDT,
       I_WGLU, I_BGLU, I_WA, I_WB, I_WOUT, I_GFFN, I_WGATE, I_WUP, I_WDOWN, I_GPLE, I_WPLE, I_WPG, I_GFIN };

namespace pg8 {
constexpr int BM = 256, BK = 64, HALF = 128, HTB = HALF * BK * 2, NXCD = 8, WGM = 8;
__host__ __device__ __forceinline__ int lds_byte(int r, int c) { const int st = (r >> 4) * 2 + (c >> 5), rr = r & 15, cc = c & 31, ob = rr * 64 + cc * 2; return st * 1024 + (ob ^ (((ob >> 9) & 1) << 5)); }
__host__ __device__ __forceinline__ void stage_rc(int b, int& R, int& C) { const int st = b / 1024, sb = b % 1024, swz = sb ^ (((sb >> 9) & 1) << 5); R = (st >> 1) * 16 + swz / 64; C = (st & 1) * 32 + (swz % 64) / 2; }
__host__ __device__ __forceinline__ int perm32(int rho) { const int n = rho >> 4, i = rho & 15; return 8 * (i >> 2) + 4 * n + (i & 3); }
struct Unit { int pm, pn; };
struct Gemm { const bf16* A; const bf16* Bt; int M, N, K; int ld; };
struct StaticOrder {
    int nM, nN, nwg, G, c;
    __host__ __device__ void init(int M, int N, int G_, int c_) { nM = M / BM; nN = N / BM; nwg = nM * nN; G = G_; c = c_; }
    __host__ __device__ bool next(int i, Unit& u) const {
        const long L = (long)i * G + c; if (L >= nwg) return false;
        int wgid = (int)L; { const int q = nwg / NXCD, r = nwg % NXCD, xcd = wgid % NXCD, off = wgid / NXCD; wgid = (xcd < r ? xcd * (q + 1) : r * (q + 1) + (xcd - r) * q) + off; }
        const int nig = WGM * nN, gid = wgid / nig, fm = gid * WGM, gsz = (nM - fm) < WGM ? (nM - fm) : WGM;
        u.pm = fm + ((wgid % nig) % gsz); u.pn = (wgid % nig) / gsz; return true;
    }
    __device__ __forceinline__ void a_ready(const Unit&) const {}
    __device__ __forceinline__ void done(const Unit&) const {}
};

template <class Epi, class Sched, bool ALIGN_EPI = true, bool SP2 = true>
__device__ __forceinline__ void gemm_phase(LAS unsigned char* lds, const Gemm g, const Sched& S, const Epi& E) {
    int tid = threadIdx.x; asm volatile("" : "+v"(tid));
    const int wid = __builtin_amdgcn_readfirstlane(tid >> 6), lane = tid & 63, wr = wid >> 2, wc = wid & 3, fr = lane & 15, fq = lane >> 4;
    const int K = g.ld ? g.ld : g.K, nt = g.K / BK;
    unsigned voffA[2], voffB[2];
#pragma unroll
    for (int i = 0; i < 2; ++i) { int R, C; stage_rc(tid * 16 + i * 8192, R, C); const int Rb = Epi::PERM ? ((R & ~31) + perm32(R & 31)) : R;
        voffA[i] = (unsigned)(R * K + C) * 2u; voffB[i] = (unsigned)(Rb * K + C) * 2u; }
    const size_t kstep = (size_t)(BK * 2);
    const size_t hstep = (size_t)HALF * K * 2;
    const size_t tstep = 2 * hstep;
    const unsigned ldsw = (unsigned)wid * 1024u;
    const int aoff = lds_byte(wr * 64 + fr, fq * 8), boff = lds_byte(wc * 32 + fr, fq * 8);
#define PG8_SA(b, h) (((b) * 2 + (h)) * HTB)
#define PG8_SB(b, h) ((4 + (b) * 2 + (h)) * HTB)
#define PG8_STAGE(bufoff, gbase, voff) do { _Pragma("unroll") for (int _i = 0; _i < 2; ++_i) \
        __builtin_amdgcn_global_load_lds((const unsigned*)((const char*)(gbase) + (voff)[_i]), (LAS unsigned*)(lds + (bufoff) + ldsw + _i * 8192), 16, 0, 0); } while (0)
#define PG8_LDA(dst, b, h) do { _Pragma("unroll") for (int m = 0; m < 4; ++m) _Pragma("unroll") for (int k = 0; k < 2; ++k) dst[m][k] = *(const LAS bf16x8*)(lds + PG8_SA(b, h) + aoff + m * 2048 + k * 1024); } while (0)
#define PG8_LDB(dst, b, h) do { _Pragma("unroll") for (int n = 0; n < 2; ++n) _Pragma("unroll") for (int k = 0; k < 2; ++k) dst[n][k] = *(const LAS bf16x8*)(lds + PG8_SB(b, h) + boff + n * 2048 + k * 1024); } while (0)
#define PG8_MMA(ai, bj, At, Bt) do { __builtin_amdgcn_s_setprio(1); _Pragma("unroll") for (int m = 0; m < 4; ++m) _Pragma("unroll") for (int n = 0; n < 2; ++n) _Pragma("unroll") for (int k = 0; k < 2; ++k) \
        acc[ai][bj][m][n] = __builtin_amdgcn_mfma_f32_16x16x32_bf16(Bt[n][k], At[m][k], acc[ai][bj][m][n], 0, 0, 0); __builtin_amdgcn_s_setprio(0); } while (0)
#define PG8_WAIT_V(n) asm volatile("s_waitcnt vmcnt(" #n ")" ::: "memory")
#define PG8_WAIT_L(n) asm volatile("s_waitcnt lgkmcnt(" #n ")" ::: "memory")
#define PG8_BAR __builtin_amdgcn_s_barrier()
#define PG8_SCHED __builtin_amdgcn_sched_barrier(0)
    Unit cur, nxt; int ui = 0;
    if (!S.next(0, cur)) return;
    f32x4 acc[2][2][4][2];
#pragma unroll
    for (int a = 0; a < 2; ++a)
#pragma unroll
        for (int b = 0; b < 2; ++b)
#pragma unroll
            for (int m = 0; m < 4; ++m)
#pragma unroll
                for (int n = 0; n < 2; ++n) acc[a][b][m][n] = (f32x4){0.f, 0.f, 0.f, 0.f};
    bf16x8 At[4][2], B0[2][2], B1[2][2];
    const char* cA = (const char*)g.A + (size_t)cur.pm * tstep; const char* cB = (const char*)g.Bt + (size_t)cur.pn * tstep;
    S.a_ready(cur);
    if constexpr (SP2) {
        PG8_STAGE(PG8_SB(0, 0), cB, voffB); PG8_STAGE(PG8_SB(0, 1), cB + hstep, voffB); PG8_STAGE(PG8_SA(0, 0), cA, voffA); PG8_STAGE(PG8_SA(0, 1), cA + hstep, voffA);
        if (wr == 1) PG8_BAR;
        PG8_WAIT_V(2); PG8_BAR;
        PG8_STAGE(PG8_SB(1, 0), cB + kstep, voffB); PG8_STAGE(PG8_SA(1, 0), cA + kstep, voffA); PG8_STAGE(PG8_SB(1, 1), cB + hstep + kstep, voffB);
        PG8_WAIT_V(6); PG8_BAR;
    } else {
        PG8_STAGE(PG8_SB(0, 0), cB, voffB); PG8_STAGE(PG8_SA(0, 0), cA, voffA); PG8_STAGE(PG8_SB(0, 1), cB + hstep, voffB); PG8_STAGE(PG8_SA(0, 1), cA + hstep, voffA);
        if (wr == 1) PG8_BAR;
        PG8_WAIT_V(4); PG8_BAR;
        PG8_STAGE(PG8_SB(1, 0), cB + kstep, voffB); PG8_STAGE(PG8_SA(1, 0), cA + kstep, voffA); PG8_STAGE(PG8_SB(1, 1), cB + hstep + kstep, voffB);
        PG8_WAIT_V(6); PG8_BAR;
    }
    for (;;) {
        const bool has_next = S.next(ui + 1, nxt);
        const char* nA = has_next ? (const char*)g.A + (size_t)nxt.pm * tstep : cA; const char* nB = has_next ? (const char*)g.Bt + (size_t)nxt.pn * tstep : cB;
        for (int t = 0; t < nt; t += 2) {
            const bool last = (t == nt - 2);
            const char* a1 = cA + (size_t)(t + 1) * kstep;
            const char* a2 = last ? nA : cA + (size_t)(t + 2) * kstep; const char* b2 = last ? nB : cB + (size_t)(t + 2) * kstep;
            const char* a3 = a2 + kstep; const char* b3 = b2 + kstep;
            if (last && has_next) S.a_ready(nxt);
            if constexpr (Epi::MID_T >= 0) { if (t == Epi::MID_T) E.mid(acc, cur, wr, wc, fr, fq); }
            if constexpr (SP2) {
            PG8_LDB(B0, 0, 0); PG8_LDB(B1, 0, 1); PG8_SCHED; PG8_LDA(At, 0, 0); PG8_STAGE(PG8_SA(1, 1), a1 + hstep, voffA);
            PG8_WAIT_V(8); PG8_WAIT_L(0); PG8_BAR; PG8_MMA(0, 0, At, B0); PG8_MMA(0, 1, At, B1); PG8_BAR; PG8_SCHED;
            PG8_LDA(At, 0, 1); PG8_STAGE(PG8_SB(0, 0), b2, voffB); PG8_STAGE(PG8_SB(0, 1), b2 + hstep, voffB); PG8_STAGE(PG8_SA(0, 0), a2, voffA);
            PG8_WAIT_V(8); PG8_WAIT_L(0); PG8_BAR; PG8_MMA(1, 0, At, B0); PG8_MMA(1, 1, At, B1); PG8_BAR; PG8_SCHED;
            PG8_LDB(B0, 1, 0); PG8_LDB(B1, 1, 1); PG8_SCHED; PG8_LDA(At, 1, 0); PG8_STAGE(PG8_SA(0, 1), a2 + hstep, voffA);
            PG8_WAIT_V(8); PG8_WAIT_L(0); PG8_BAR; PG8_MMA(0, 0, At, B0); PG8_MMA(0, 1, At, B1); PG8_BAR; PG8_SCHED;
            PG8_LDA(At, 1, 1); PG8_STAGE(PG8_SB(1, 0), b3, voffB); PG8_STAGE(PG8_SB(1, 1), b3 + hstep, voffB); PG8_STAGE(PG8_SA(1, 0), a3, voffA);
            PG8_WAIT_V(8); PG8_WAIT_L(0); PG8_BAR; PG8_MMA(1, 0, At, B0); PG8_MMA(1, 1, At, B1); PG8_BAR; PG8_SCHED;
            } else {
            PG8_LDB(B0, 0, 0); PG8_SCHED; PG8_LDA(At, 0, 0); PG8_STAGE(PG8_SA(1, 1), a1 + hstep, voffA);
            PG8_WAIT_L(8); PG8_BAR; PG8_WAIT_L(0); PG8_MMA(0, 0, At, B0); PG8_BAR; PG8_SCHED;
            PG8_LDB(B1, 0, 1); PG8_STAGE(PG8_SB(0, 0), b2, voffB);
            PG8_BAR; PG8_WAIT_L(0); PG8_MMA(0, 1, At, B1); PG8_BAR;
            PG8_LDA(At, 0, 1); PG8_STAGE(PG8_SA(0, 0), a2, voffA);
            PG8_BAR; PG8_WAIT_L(0); PG8_MMA(1, 0, At, B0); PG8_BAR; PG8_SCHED;
            PG8_STAGE(PG8_SB(0, 1), b2 + hstep, voffB);
            PG8_WAIT_V(6); PG8_BAR; PG8_MMA(1, 1, At, B1); PG8_BAR;
            PG8_LDB(B0, 1, 0); PG8_SCHED; PG8_LDA(At, 1, 0); PG8_STAGE(PG8_SA(0, 1), a2 + hstep, voffA);
            PG8_WAIT_L(8); PG8_BAR; PG8_WAIT_L(0); PG8_MMA(0, 0, At, B0); PG8_BAR; PG8_SCHED;
            PG8_LDB(B1, 1, 1); PG8_STAGE(PG8_SB(1, 0), b3, voffB);
            PG8_BAR; PG8_WAIT_L(0); PG8_MMA(0, 1, At, B1); PG8_BAR;
            PG8_LDA(At, 1, 1); PG8_STAGE(PG8_SA(1, 0), a3, voffA);
            PG8_BAR; PG8_WAIT_L(0); PG8_MMA(1, 0, At, B0); PG8_BAR; PG8_SCHED;
            PG8_STAGE(PG8_SB(1, 1), b3 + hstep, voffB);
            PG8_WAIT_V(6); PG8_BAR; PG8_MMA(1, 1, At, B1); PG8_BAR;
            }
        }
        if constexpr (ALIGN_EPI) { if (wr == 0) PG8_BAR; }
        E(acc, cur, wr, wc, fr, fq); S.done(cur);
        if (!has_next) break;
#pragma unroll
        for (int a = 0; a < 2; ++a)
#pragma unroll
            for (int b = 0; b < 2; ++b)
#pragma unroll
                for (int m = 0; m < 4; ++m)
#pragma unroll
                    for (int n = 0; n < 2; ++n) acc[a][b][m][n] = (f32x4){0.f, 0.f, 0.f, 0.f};
        cur = nxt; cA = nA; cB = nB; ++ui;
        if constexpr (ALIGN_EPI) { if (wr == 1) PG8_BAR; }
    }
    PG8_WAIT_V(0);
    if constexpr (!ALIGN_EPI) { if (wr == 0) PG8_BAR; }
    PG8_BAR;
#undef PG8_SA
#undef PG8_SB
#undef PG8_STAGE
#undef PG8_LDA
#undef PG8_LDB
#undef PG8_MMA
#undef PG8_WAIT_V
#undef PG8_WAIT_L
#undef PG8_BAR
#undef PG8_SCHED
}
}

typedef f32x4 AccT[2][2][4][2];
#define EPI_ROWS_BEGIN  _Pragma("unroll") for (int ai = 0; ai < 2; ++ai) _Pragma("unroll") for (int m = 0; m < 4; ++m) { const int row = u.pm * 256 + ai * 128 + wr * 64 + m * 16 + fr;
#define EPI_ROWS_END    asm volatile("" ::: "memory"); }
__device__ __forceinline__ u32x4 pack8(const f32x4 a, const f32x4 b) { u32x4 w; w.x = pk2(a[0], a[1]); w.y = pk2(a[2], a[3]); w.z = pk2(b[0], b[1]); w.w = pk2(b[2], b[3]); return w; }
__device__ __forceinline__ void unpack8(const u32x4 w, f32x4& a, f32x4& b) { a = (f32x4){bflo(w.x), bfhi(w.x), bflo(w.y), bfhi(w.y)}; b = (f32x4){bflo(w.z), bfhi(w.z), bflo(w.w), bfhi(w.w)}; }
__device__ __forceinline__ f32x4 sig4(f32x4 v) { return (f32x4){sigmoidf_(v[0]), sigmoidf_(v[1]), sigmoidf_(v[2]), sigmoidf_(v[3])}; }
__device__ __forceinline__ float ssq8(const f32x4 a, const f32x4 b) { return (a[0] * a[0] + a[1] * a[1]) + (a[2] * a[2] + a[3] * a[3]) + (b[0] * b[0] + b[1] * b[1]) + (b[2] * b[2] + b[3] * b[3]); }

struct EpiProj {
    static constexpr bool PERM = true; static constexpr int MID_T = -1;
    bf16* P; float* BA;
    __device__ __forceinline__ void operator()(const AccT& acc, const pg8::Unit& u, int wr, int wc, int fr, int fq) const {
        if (u.pn < 36) {
            const int col0 = u.pn * 256 + wc * 32 + 8 * fq;
            EPI_ROWS_BEGIN
                bf16* rp = P + (size_t)row * NPROJ + col0;
#pragma unroll
                for (int bj = 0; bj < 2; ++bj) *(u32x4*)(rp + bj * 128) = pack8(acc[ai][bj][m][0], acc[ai][bj][m][1]);
            EPI_ROWS_END
        } else if (wc == 0 && fq < 2) {
            EPI_ROWS_BEGIN
                float* rp = BA + (size_t)row * 16 + 8 * fq;
                *(f32x4*)rp = acc[ai][0][m][0]; *(f32x4*)(rp + 4) = acc[ai][0][m][1];
            EPI_ROWS_END
        }
    }
};
struct EpiGlu {
    static constexpr bool PERM = true; static constexpr int MID_T = -1;
    const bf16* YG; bf16* YS; const float* bias;
    __device__ __forceinline__ void operator()(const AccT& acc, const pg8::Unit& u, int wr, int wc, int fr, int fq) const {
        const int col0 = u.pn * 256 + wc * 32 + 8 * fq;
        f32x4 bv[2][2];
#pragma unroll
        for (int bj = 0; bj < 2; ++bj) { bv[bj][0] = *(const f32x4*)(bias + col0 + bj * 128); bv[bj][1] = *(const f32x4*)(bias + col0 + bj * 128 + 4); }
        EPI_ROWS_BEGIN
#pragma unroll
            for (int bj = 0; bj < 2; ++bj) { const size_t off = (size_t)row * 1024 + col0 + bj * 128;
                f32x4 y0, y1; unpack8(*(const u32x4*)(YG + off), y0, y1);
                const f32x4 o0 = y0 * sig4(acc[ai][bj][m][0] + bv[bj][0]), o1 = y1 * sig4(acc[ai][bj][m][1] + bv[bj][1]);
                *(u32x4*)(YS + (size_t)row * DM + col0 + bj * 128) = pack8(o0, o1); }
        EPI_ROWS_END
    }
};
struct EpiMix {
    static constexpr bool PERM = true; static constexpr int MID_T = 16;
    const bf16* P; bf16* MIX;
    __device__ __forceinline__ void mid(AccT& acc, const pg8::Unit& u, int wr, int wc, int fr_, int fq) const {
        int fr = fr_; asm volatile("" : "+v"(fr));
        const int col0 = u.pn * 256 + wc * 32 + 8 * fq;
        EPI_ROWS_BEGIN
            const bf16* gp = P + (size_t)row * NPROJ + 5120 + col0;
#pragma unroll
            for (int bj = 0; bj < 2; ++bj) {
                f32x4 a0, a1, b0, b1; unpack8(*(const u32x4*)(gp + bj * 128), a0, a1); unpack8(*(const u32x4*)(gp + 2048 + bj * 128), b0, b1);
#pragma unroll
                for (int q = 0; q < 4; ++q) { acc[ai][bj][m][0][q] *= (1.f + __expf(-b0[q])) * __builtin_amdgcn_rcpf(1.f + __expf(-a0[q])); acc[ai][bj][m][1][q] *= (1.f + __expf(-b1[q])) * __builtin_amdgcn_rcpf(1.f + __expf(-a1[q])); }
                asm volatile("" ::: "memory"); }
        EPI_ROWS_END
    }
    __device__ __forceinline__ void operator()(const AccT& acc, const pg8::Unit& u, int wr, int wc, int fr, int fq) const {
        const int col0 = u.pn * 256 + wc * 32 + 8 * fq;
        EPI_ROWS_BEGIN
#pragma unroll
            for (int bj = 0; bj < 2; ++bj) { const int c = col0 + bj * 128;
                f32x4 g0, g1; unpack8(*(const u32x4*)(P + (size_t)row * NPROJ + 7168 + c), g0, g1);
                *(u32x4*)(MIX + (size_t)row * DM + c) = pack8(sig4(g0) * acc[ai][bj][m][0], sig4(g1) * acc[ai][bj][m][1]); }
        EPI_ROWS_END
    }
};
struct EpiResid {
    static constexpr bool PERM = true; static constexpr int MID_T = -1;
    const float* b0; const float* b1; float* XO; bf16* XG; const float* gw; float* ssq;
    __device__ __forceinline__ void operator()(const AccT& acc, const pg8::Unit& u, int wr, int wc, int fr, int fq) const {
        const int col0 = u.pn * 256 + wc * 32 + 8 * fq;
        f32x4 gv[2][2];
#pragma unroll
        for (int bj = 0; bj < 2; ++bj) { gv[bj][0] = *(const f32x4*)(gw + col0 + bj * 128); gv[bj][1] = *(const f32x4*)(gw + col0 + bj * 128 + 4); }
        EPI_ROWS_BEGIN
            const float* bp = (row < TP ? b0 + (size_t)row * DM : b1 + (size_t)(row - TP) * DM) + col0;
            float s = 0.f;
#pragma unroll
            for (int bj = 0; bj < 2; ++bj) { const int c = col0 + bj * 128;
                const f32x4 o0 = ldnt4(bp + bj * 128) + acc[ai][bj][m][0], o1 = ldnt4(bp + bj * 128 + 4) + acc[ai][bj][m][1];
                float* xp = XO + (size_t)row * DM + c; *(f32x4*)xp = o0; *(f32x4*)(xp + 4) = o1;
                *(u32x4*)(XG + (size_t)row * DM + c) = pack8(o0 * gv[bj][0], o1 * gv[bj][1]);
                s += ssq8(o0, o1); }
            s += __shfl_xor(s, 16); s += __shfl_xor(s, 32);
            if (fq == 0) atomicAdd(ssq + row, s);
        EPI_ROWS_END
    }
};
struct EpiGU {
    static constexpr bool PERM = true; static constexpr int MID_T = -1;
    const float* ssq; bf16* ACT;
    __device__ __forceinline__ void operator()(const AccT& acc, const pg8::Unit& u, int wr, int wc, int fr, int fq) const {
        const int col0 = u.pn * 128 + wc * 32 + 8 * fq;
        EPI_ROWS_BEGIN
            const float rs = __builtin_amdgcn_rsqf(ssq[row] * (1.f / DM) + EPS);
            f32x4 o[2];
#pragma unroll
            for (int n = 0; n < 2; ++n) { const f32x4 g = acc[ai][0][m][n] * rs, up = acc[ai][1][m][n] * rs;
                o[n] = (f32x4){siluf_(g[0]) * up[0], siluf_(g[1]) * up[1], siluf_(g[2]) * up[2], siluf_(g[3]) * up[3]}; }
            *(u32x4*)(ACT + (size_t)row * FF + col0) = pack8(o[0], o[1]);
        EPI_ROWS_END
    }
};
struct EpiF32 {
    static constexpr bool PERM = true; static constexpr int MID_T = -1;
    float* C;
    __device__ __forceinline__ void operator()(const AccT& acc, const pg8::Unit& u, int wr, int wc, int fr, int fq) const {
        const int col0 = u.pn * 256 + wc * 32 + 8 * fq;
        EPI_ROWS_BEGIN
#pragma unroll
            for (int bj = 0; bj < 2; ++bj) { float* tp = C + (size_t)row * DM + col0 + bj * 128; *(f32x4*)tp = acc[ai][bj][m][0]; *(f32x4*)(tp + 4) = acc[ai][bj][m][1]; }
        EPI_ROWS_END
    }
};
struct TailOrder {
    int c;
    __device__ bool next(int i, pg8::Unit& u) const { if (i != 0) return false; u.pm = 32 + (c >> 6); u.pn = (c >> 3) & 7; return true; }
    __device__ __forceinline__ void a_ready(const pg8::Unit&) const {}
    __device__ __forceinline__ void done(const pg8::Unit&) const {}
};
struct EpiSlab {
    static constexpr bool PERM = true; static constexpr int MID_T = -1;
    float* C;
    __device__ __forceinline__ void operator()(const AccT& acc, const pg8::Unit& u, int wr, int wc, int fr, int fq) const {
        const int col0 = u.pn * 256 + wc * 32 + 8 * fq;
        EPI_ROWS_BEGIN
#pragma unroll
            for (int bj = 0; bj < 2; ++bj) { float* tp = C + (size_t)(row - TP) * DM + col0 + bj * 128; *(f32x4*)tp = acc[ai][bj][m][0]; *(f32x4*)(tp + 4) = acc[ai][bj][m][1]; }
        EPI_ROWS_END
    }
};
struct EpiPleB {
    static constexpr bool PERM = true; static constexpr int MID_T = -1;
    float* X; const float* TPLE; const float* ssq_in; float* ssq_out;
    __device__ __forceinline__ void operator()(const AccT& acc, const pg8::Unit& u, int wr, int wc, int fr, int fq) const {
        const int col0 = u.pn * 256 + wc * 32 + 8 * fq;
        EPI_ROWS_BEGIN
            const float rs = __builtin_amdgcn_rsqf(ssq_in[row] * (1.f / DM) + EPS);
            float s = 0.f;
            float* xp = X + (size_t)row * DM + col0; const float* tp = TPLE + (size_t)row * DM + col0;
#pragma unroll
            for (int bj = 0; bj < 2; ++bj) {
#pragma unroll
                for (int n = 0; n < 2; ++n) { const f32x4 o = ldnt4(xp + bj * 128 + 4 * n) + ldnt4(tp + bj * 128 + 4 * n) * sig4(acc[ai][bj][m][n] * rs);
                    *(f32x4*)(xp + bj * 128 + 4 * n) = o; s += (o[0] * o[0] + o[1] * o[1]) + (o[2] * o[2] + o[3] * o[3]); asm volatile("" ::: "memory"); } }
            s += __shfl_xor(s, 16); s += __shfl_xor(s, 32);
            if (fq == 0) atomicAdd(ssq_out + row, s);
        EPI_ROWS_END
    }
};

#define XB_TMO      128
#define XB_XCNT(j)  (256  + 64 * (j))
#define XB_XSUB(j)  (1280 + 64 * (j))
#define XB_XGEN(j)  (2304 + 64 * (j))
#define XB_TOP      3328
#define XB_TOPGEN   3392
#define XCD_BAR_WORDS 3456
#define XB_SPIN_CAP (1u << 20)
__device__ __forceinline__ unsigned xb_ld(unsigned* p)              { return __hip_atomic_load(p, __ATOMIC_RELAXED, __HIP_MEMORY_SCOPE_AGENT); }
__device__ __forceinline__ unsigned xb_add(unsigned* p, unsigned v) { return __hip_atomic_fetch_add(p, v, __ATOMIC_RELAXED, __HIP_MEMORY_SCOPE_AGENT); }
__device__ __forceinline__ unsigned xb_xcc_id() { return (unsigned)__builtin_amdgcn_s_getreg((3 << 11) | 20) & 0xFu; }
#define XB_SPIN(cond, bar) do { unsigned _sp = 0; while (cond) { __builtin_amdgcn_s_sleep(1); \
    if ((++_sp & 255u) == 0u) { if (xb_ld(&(bar)[XB_TMO])) break; if (_sp > XB_SPIN_CAP) { atomicAdd(&(bar)[XB_TMO], 1u); break; } } } } while (0)
struct XcdBarrier { unsigned* bar; unsigned x; volatile LAS unsigned* st; };
__device__ __forceinline__ XcdBarrier xcd_barrier_post(unsigned* bar, volatile LAS unsigned* st) {
    XcdBarrier b; b.bar = bar; b.x = xb_xcc_id(); b.st = st;
    if (threadIdx.x == 0) (void)xb_add(&bar[XB_XCNT(b.x)], 1u);
    return b;
}
__device__ __forceinline__ void xcd_barrier_complete(unsigned* bar, unsigned x, unsigned& nloc, unsigned& nx) {
    const unsigned G = gridDim.x * gridDim.y * gridDim.z;
    unsigned sum, cnt, mine, sp = 0u;
    for (;;) {
        sum = 0u; cnt = 0u; mine = 0u;
#pragma unroll
        for (unsigned j = 0; j < 16; ++j) { const unsigned c = xb_ld(&bar[XB_XCNT(j)]); sum += c; cnt += (c > 0u) ? 1u : 0u; mine = (j == x) ? c : mine; }
        if (sum == G) break;
        __builtin_amdgcn_s_sleep(1);
        if ((++sp & 255u) == 0u) { if (xb_ld(&bar[XB_TMO])) break; if (sp > XB_SPIN_CAP) { atomicAdd(&bar[XB_TMO], 1u); break; } }
    }
    nloc = mine > 0u ? mine : 1u; nx = cnt > 0u ? cnt : 1u;
}
__device__ __forceinline__ void xcd_barrier(const XcdBarrier& b) {
    asm volatile("s_waitcnt vmcnt(0)" ::: "memory");
    __syncthreads();
    if (threadIdx.x == 0) {
        unsigned* bar = b.bar;
        __builtin_amdgcn_s_waitcnt(0);
        unsigned nloc = b.st[0], nx = b.st[1];
        if (nloc == 0u) { xcd_barrier_complete(bar, b.x, nloc, nx); b.st[0] = nloc; b.st[1] = nx; }
        const unsigned old = xb_add(&bar[XB_XSUB(b.x)], 1u);
        const unsigned gen = old / nloc;
        if (old + 1u == (gen + 1u) * nloc) {
            __builtin_amdgcn_fence(__ATOMIC_RELEASE, "agent");
            asm volatile("s_waitcnt vmcnt(0)" ::: "memory");
            const unsigned og = xb_add(&bar[XB_TOP], 1u);
            const unsigned tg = og / nx;
            if (og + 1u == (tg + 1u) * nx) xb_add(&bar[XB_TOPGEN], 1u);
            else XB_SPIN(xb_ld(&bar[XB_TOPGEN]) == tg, bar);
            __builtin_amdgcn_fence(__ATOMIC_ACQUIRE, "agent");
            xb_add(&bar[XB_XGEN(b.x)], 1u);
            asm volatile("s_waitcnt vmcnt(0)" ::: "memory");
        } else {
            XB_SPIN(xb_ld(&bar[XB_XGEN(b.x)]) == gen, bar);
            __builtin_amdgcn_fence(__ATOMIC_ACQUIRE, "agent");
            asm volatile("s_waitcnt vmcnt(0)" ::: "memory");
        }
    }
    __syncthreads();
}

__device__ __forceinline__ float wave_sum(float v) {
#pragma unroll
    for (int o = 1; o < 64; o <<= 1) v += __shfl_xor(v, o);
    return v;
}
__device__ __forceinline__ void tr_item(const float* W, int ldw, int c0, int k0, bf16* WT, int K, int r0, int nw, LAS float* scr, int lane) {
    const int nn = lane & 31;
    float tv[32];
    const float* src = W + (size_t)(k0 + (lane >> 5)) * ldw + c0 + nn;
#pragma unroll
    for (int i = 0; i < 32; ++i) tv[i] = (nn < nw) ? __builtin_nontemporal_load(src + (size_t)(2 * i) * ldw) : 0.f;
#pragma unroll
    for (int i = 0; i < 32; ++i) scr[(2 * i + (lane >> 5)) * 33 + nn] = tv[i];
    LDS_WAIT(); asm volatile("" ::: "memory");
    const int c = lane & 7;
#pragma unroll
    for (int j = 0; j < 4; ++j) { const int n = (lane >> 3) + 8 * j; const LAS float* s = scr + (8 * c) * 33 + n;
        u32x4 o; o.x = pk2(s[0 * 33], s[1 * 33]); o.y = pk2(s[2 * 33], s[3 * 33]); o.z = pk2(s[4 * 33], s[5 * 33]); o.w = pk2(s[6 * 33], s[7 * 33]);
        if (n < nw) *(u32x4*)(WT + (size_t)(r0 + n) * K + k0 + 8 * c) = o; }
    LDS_WAIT(); asm volatile("" ::: "memory");
}

__device__ __forceinline__ f32x2 cmul(f32x2 a, f32x2 b) { return (f32x2){a[0] * b[0] - a[1] * b[1], a[0] * b[1] + a[1] * b[0]}; }
__device__ __forceinline__ f32x2 cfma(f32x2 a, f32x2 b, f32x2 c) {
    const f32x2 bx = __builtin_shufflevector(b, b, 0, 0), by = __builtin_shufflevector(b, b, 1, 1);
    const f32x2 ar = (f32x2){-a[1], a[0]};
    return __builtin_elementwise_fma(bx, a, __builtin_elementwise_fma(by, ar, c));
}
__device__ __forceinline__ f32x2 shfl2(f32x2 v, int src) { return (f32x2){__shfl(v[0], src), __shfl(v[1], src)}; }
__device__ __forceinline__ f32x2 shflup2(f32x2 v, int d) { return (f32x2){__shfl_up(v[0], d), __shfl_up(v[1], d)}; }
__device__ __forceinline__ float bf_round(float x) { return bflo(pk2(x, 0.f)); }
struct S5W { f32x2 lam[4], lam4[4], lam8[4], lamin[4]; bf16x8 bf[8]; };
__device__ __forceinline__ void s5_state_params(const Args& a, int g, int n, f32x2& lam, f32x2& cc) {
    const float dt = expf(a.in[I_S5LDT][g]);
    const float ar = a.in[I_S5AR][g * 64 + n], ai = a.in[I_S5AI][g * 64 + n];
    const float mag = expf(ar * dt);
    const double x = (double)ai * (double)dt;
    const double kq = rint(x * 0.15915494309189535), r = x - kq * 6.283185307179586, r2 = r * r;
    double ts = r, ss = r, tc = 1.0, sc = 1.0;
#pragma unroll
    for (int k = 0; k < 12; ++k) { ts *= -r2 * (1.0 / (double)((2 * k + 2) * (2 * k + 3))); ss += ts; tc *= -r2 * (1.0 / (double)((2 * k + 1) * (2 * k + 2))); sc += tc; }
    const float lr = mag * (float)sc, li = mag * (float)ss;
    const float nr = lr - 1.f, ni = li, den = ar * ar + ai * ai;
    lam = (f32x2){lr, li}; cc = (f32x2){(nr * ar + ni * ai) / den, (ni * ar - nr * ai) / den};
}
__device__ __forceinline__ void s5_setup(const Args& a, int g, int l, S5W& W, const f32x2 lamS, const f32x2 ccS) {
    const int col = l & 15, rg = l >> 4;
#pragma unroll
    for (int j = 0; j < 4; ++j) {
        const int n = 16 * j + col;
        const f32x2 lam = shfl2(lamS, n), cj = shfl2(ccS, n);
        const f32x2 l2 = cmul(lam, lam), l4 = cmul(l2, l2), l8 = cmul(l4, l4);
        W.lam[j] = lam; W.lam4[j] = rg >= 1 ? l4 : (f32x2){0.f, 0.f}; W.lam8[j] = rg >= 2 ? l8 : (f32x2){0.f, 0.f};
        W.lamin[j] = rg == 0 ? (f32x2){1.f, 0.f} : rg == 1 ? l4 : rg == 2 ? l8 : cmul(l8, l4);
        const float* br = a.in[I_S5BR] + (size_t)(g * 64 + n) * 16 + 8 * (rg & 1); const float* bi = a.in[I_S5BI] + (size_t)(g * 64 + n) * 16 + 8 * (rg & 1);
        const f32x4 r0 = *(const f32x4*)br, r1 = *(const f32x4*)(br + 4), i0 = *(const f32x4*)bi, i1 = *(const f32x4*)(bi + 4);
        f32x4 xr0 = r0 * cj[0] - i0 * cj[1], xr1 = r1 * cj[0] - i1 * cj[1], xi0 = i0 * cj[0] + r0 * cj[1], xi1 = i1 * cj[0] + r1 * cj[1];
        if (rg >= 2) {
#pragma unroll
            for (int q = 0; q < 4; ++q) { xr0[q] -= bf_round(xr0[q]); xr1[q] -= bf_round(xr1[q]); xi0[q] -= bf_round(xi0[q]); xi1[q] -= bf_round(xi1[q]); }
        }
        W.bf[j] = __builtin_bit_cast(bf16x8, pack8(xr0, xr1)); W.bf[4 + j] = __builtin_bit_cast(bf16x8, pack8(xi0, xi1));
    }
}
__device__ __forceinline__ u32x4 s5_load_u(const bf16* PROJ, int tok0, int g, int nvalid, int l) {
    const int col = l & 15, rg = l >> 4;
    u32x4 au = (u32x4){0u, 0u, 0u, 0u};
    if (col < nvalid) au = *(const u32x4*)(PROJ + (size_t)(tok0 + col) * NPROJ + g * 16 + 8 * (rg & 1));
    return au;
}
__device__ __forceinline__ void s5_bu_tile(const u32x4 au, const S5W& W, f32x4 (&d)[8]) {
    const bf16x8 av = __builtin_bit_cast(bf16x8, au);
#pragma unroll
    for (int jt = 0; jt < 8; ++jt) d[jt] = __builtin_amdgcn_mfma_f32_16x16x32_bf16(av, W.bf[jt], (f32x4){0.f, 0.f, 0.f, 0.f}, 0, 0, 0);
}
__device__ __forceinline__ void s5_scan_block(const S5W& W, int j, int rg, const f32x4& dre, const f32x4& dim, f32x2 hin, f32x2 (&h)[4]) {
    const f32x2 b0 = (f32x2){dre[0], dim[0]}, b1 = (f32x2){dre[1], dim[1]}, b2 = (f32x2){dre[2], dim[2]}, b3 = (f32x2){dre[3], dim[3]};
    const f32x2 l3 = cfma(W.lam[j], cfma(W.lam[j], cfma(W.lam[j], b0, b1), b2), b3);
    f32x2 P = l3, t;
    t = shflup2(P, 16); P = cfma(W.lam4[j], t, P);
    t = shflup2(P, 32); P = cfma(W.lam8[j], t, P);
    const float m1 = rg >= 1 ? 1.f : 0.f;
    const f32x2 e = shflup2(P, 16) * m1;
    const f32x2 cin = cfma(W.lamin[j], hin, e);
    h[0] = cfma(W.lam[j], cin, b0); h[1] = cfma(W.lam[j], h[0], b1); h[2] = cfma(W.lam[j], h[1], b2); h[3] = cfma(W.lam[j], h[2], b3);
}

struct Ctx { LAS unsigned char* lds; int tid, lane, wave, G, blk; };

constexpr int I_IN = 32 * 288, I_BA = 32, I_GLU = 16 * 32, I_AB = 16 * 64, I_OUT = 32 * 64, I_GU = 32 * 176, I_DN = 88 * 64, I_PL = 4 * 64;
constexpr int CV_EARLY = I_IN + I_BA + I_GLU + 2 * I_AB + I_OUT, CV_ALL = CV_EARLY + I_OUT + 2 * I_GU + I_DN + I_PL;
constexpr int P1_GEMM_WGS = 222;
__device__ __forceinline__ void conv_range(const Args& a, const Ctx& c, int lo, int hi, int gw, int NGW) {
    unsigned char* ws = a.ws;
    LAS float* scr = (LAS float*)(c.lds + c.wave * 16384);
    for (int it = lo + gw; it < hi; it += NGW) {
        int r = it;
        if (r < I_IN) { const int kb = r / 288, nb = r % 288, r0 = 32 * nb, c0 = r0 + (r0 >= 5120 ? 16 : 0); tr_item(a.in[I_WIN], NIN, c0, 64 * kb, (bf16*)(ws + WS_WIN), DM, r0, 32, scr, c.lane); continue; } r -= I_IN;
        if (r < I_BA) { tr_item(a.in[I_WIN], NIN, 5120, 64 * r, (bf16*)(ws + WS_WIN), DM, 9216, 16, scr, c.lane); continue; } r -= I_BA;
        if (r < I_GLU) { const int kb = r / 32, nb = r % 32; tr_item(a.in[I_WGLU], 1024, 32 * nb, 64 * kb, (bf16*)(ws + WS_WGLU), 1024, 32 * nb, 32, scr, c.lane); continue; } r -= I_GLU;
        if (r < I_AB) { const int kb = r / 64, nb = r % 64; tr_item(a.in[I_WA], DM, 32 * nb, 64 * kb, (bf16*)(ws + WS_WA), DM, 32 * nb, 32, scr, c.lane); continue; } r -= I_AB;
        if (r < I_AB) { const int kb = r / 64, nb = r % 64; tr_item(a.in[I_WB], DM, 32 * nb, 64 * kb, (bf16*)(ws + WS_WA) + 1024, DM, 32 * nb, 32, scr, c.lane); continue; } r -= I_AB;
        if (r < I_OUT) { const int kb = r / 64, nb = r % 64; tr_item(a.in[I_WOUT], DM, 32 * nb, 64 * kb, (bf16*)(ws + WS_WOUT), DM, 32 * nb, 32, scr, c.lane); continue; } r -= I_OUT;
        if (r < I_OUT) { const int kb = r / 64, nb = r % 64; tr_item(a.in[I_WPG], DM, 32 * nb, 64 * kb, (bf16*)(ws + WS_WPG), DM, 32 * nb, 32, scr, c.lane); continue; } r -= I_OUT;
        if (r < I_GU) { const int kb = r / 176, nb = r % 176; tr_item(a.in[I_WGATE], FF, 32 * nb, 64 * kb, (bf16*)(ws + WS_WGU), DM, 256 * (nb >> 2) + 32 * (nb & 3), 32, scr, c.lane); continue; } r -= I_GU;
        if (r < I_GU) { const int kb = r / 176, nb = r % 176; tr_item(a.in[I_WUP], FF, 32 * nb, 64 * kb, (bf16*)(ws + WS_WGU), DM, 256 * (nb >> 2) + 32 * (nb & 3) + 128, 32, scr, c.lane); continue; } r -= I_GU;
        if (r < I_DN) { const int kb = r / 64, nb = r % 64; tr_item(a.in[I_WDOWN], DM, 32 * nb, 64 * kb, (bf16*)(ws + WS_WDOWN), FF, 32 * nb, 32, scr, c.lane); continue; } r -= I_DN;
        { const int kb = r / 64, nb = r % 64; tr_item(a.in[I_WPLE], DM, 32 * nb, 64 * kb, (bf16*)(ws + WS_WPLE), PLE, 32 * nb, 32, scr, c.lane); }
    }
}
__device__ __forceinline__ void phase0(const Args& a, const Ctx& c) {
    unsigned char* ws = a.ws;
    const int gw = c.blk * 8 + c.wave, NGW = c.G * 8;
    conv_range(a, c, 0, CV_EARLY, gw, NGW);
    bf16* HB = (bf16*)(ws + WS_HB);
    for (int m = gw; m < TT; m += NGW) {
        const float* xr = (m < TP) ? a.in[I_XP] + (size_t)m * DM : a.in[I_XS] + (size_t)(m - TP) * DM;
        f32x4 v[8]; float s = 0.f;
#pragma unroll
        for (int j = 0; j < 8; ++j) { v[j] = ldnt4(xr + 4 * (c.lane + 64 * j)); s += (v[j][0] * v[j][0] + v[j][1] * v[j][1]) + (v[j][2] * v[j][2] + v[j][3] * v[j][3]); }
        const float rs = 1.f / sqrtf(wave_sum(s) * (1.f / DM) + EPS);
#pragma unroll
        for (int j = 0; j < 8; ++j) { const f32x4 gq = ((const f32x4*)a.in[I_GMIX])[c.lane + 64 * j]; const f32x4 o = v[j] * gq * rs;
            u32x2 w; w.x = pk2(o[0], o[1]); w.y = pk2(o[2], o[3]); ((u32x2*)(HB + (size_t)m * DM))[c.lane + 64 * j] = w; }
    }
    bf16* PB = (bf16*)(ws + WS_PB);
    const int gt = c.blk * 512 + c.tid, NGT = c.G * 512;
    for (int i = gt; i < TT * PLE / 4; i += NGT) {
        const int e = i * 4; const f32x4 v = (e < TP * PLE) ? ldnt4(a.in[I_PP] + e) : ldnt4(a.in[I_PS] + (e - TP * PLE));
        u32x2 w; w.x = pk2(v[0], v[1]); w.y = pk2(v[2], v[3]); *(u32x2*)(PB + e) = w;
    }
}

constexpr int L_KH = 0, L_QH = 17408, L_VF = 34816, L_LM = 68608, L_GC = 84992, L_BETA = 85248, L_EG = 85504;
__device__ __forceinline__ void dn_precompute(const Args& a, const Ctx& c, int item) {
    const int b = item >> 8, ch = (item >> 3) & 31, h = item & 7;
    const bf16* PROJ = (const bf16*)(a.ws + WS_PROJ);
    const float* BA = (const float*)(a.ws + WS_BA);
    unsigned char* dn = (unsigned char*)a.out + (size_t)item * DN_ITEM;
    const int tok0 = b * SEQ + ch * 64;
    LAS unsigned char* L = c.lds;
    int tid = c.tid; asm volatile("" : "+v"(tid));
    const int l = tid & 63, w = __builtin_amdgcn_readfirstlane(tid >> 6);
    float bl = 0.f, al = 0.f;
    if (w == 0) { bl = BA[(size_t)(tok0 + l) * 16 + h]; al = BA[(size_t)(tok0 + l) * 16 + 8 + h]; }
    {
        float outv[3][8][2];
        unsigned xraw[3][11];
#pragma unroll
        for (int p = 0; p < 3; ++p) {
            const int col = 1024 + p * 1024 + h * 128 + 2 * l;
#pragma unroll
            for (int i = 0; i < 11; ++i) { const int ti = ch * 64 + 8 * w + i - 3;
                xraw[p][i] = 0u; if (ti >= 0) xraw[p][i] = *(const unsigned*)(PROJ + (size_t)(b * SEQ + ti) * NPROJ + col); }
        }
#pragma unroll
        for (int p = 0; p < 3; ++p) {
            f32x2 xr[11], wt[4];
#pragma unroll
            for (int j = 0; j < 4; ++j) wt[j] = *(const f32x2*)(a.in[I_CONVW] + j * CONVC + p * 1024 + h * 128 + 2 * l);
#pragma unroll
            for (int i = 0; i < 11; ++i) xr[i] = (f32x2){bflo(xraw[p][i]), bfhi(xraw[p][i])};
#pragma unroll
            for (int t = 0; t < 8; ++t) { f32x2 s = xr[t] * wt[0] + xr[t + 1] * wt[1] + xr[t + 2] * wt[2] + xr[t + 3] * wt[3];
                outv[p][t][0] = siluf_(s[0]); outv[p][t][1] = siluf_(s[1]); }
        }
#pragma unroll
        for (int t = 0; t < 8; ++t) {
            const float sq = wave_sum(outv[0][t][0] * outv[0][t][0] + outv[0][t][1] * outv[0][t][1]);
            const float sk = wave_sum(outv[1][t][0] * outv[1][t][0] + outv[1][t][1] * outv[1][t][1]);
            const float rq = __builtin_amdgcn_rsqf(sq + EPS) * 0.08838834764831845f, rk = __builtin_amdgcn_rsqf(sk + EPS);
            const int i = 8 * w + t;
            *(LAS unsigned*)(L + L_QH + i * 272 + 4 * l) = pk2(outv[0][t][0] * rq, outv[0][t][1] * rq);
            *(LAS unsigned*)(L + L_KH + i * 272 + 4 * l) = pk2(outv[1][t][0] * rk, outv[1][t][1] * rk);
            *(LAS f32x2*)(L + L_VF + i * 528 + 8 * l) = (f32x2){outv[2][t][0], outv[2][t][1]};
        }
    }
    if (w == 0) {
        const float xx = al + a.in[I_DTB][h];
        const float sp = fmaxf(xx, 0.f) + log1pf(__expf(-fabsf(xx)));
        float g = -__expf(a.in[I_ALOG][h]) * sp;
#pragma unroll
        for (int o = 1; o < 64; o <<= 1) { const float t = __shfl_up(g, o); if (l >= o) g += t; }
        ((LAS float*)(L + L_GC))[l] = g; ((LAS float*)(L + L_BETA))[l] = sigmoidf_(bl); ((LAS float*)(L + L_EG))[l] = __expf(g);
        if (l == 63) ((float*)(a.ws + WS_GL))[item] = __expf(g);
    }
    __syncthreads();
    const LAS float* GC = (const LAS float*)(L + L_GC); const LAS float* BETA = (const LAS float*)(L + L_BETA); const LAS float* EG = (const LAS float*)(L + L_EG);
    {
        const int sel = w >> 2, mt = w & 3, fr = l & 15, fq = l >> 4;
        const LAS unsigned char* Ab = L + (sel ? L_QH : L_KH) + (16 * mt + fr) * 272 + fq * 16;
        bf16x8 af[4];
#pragma unroll
        for (int s = 0; s < 4; ++s) af[s] = *(const LAS bf16x8*)(Ab + s * 64);
#pragma unroll
        for (int nt = 0; nt < 4; ++nt) {
            f32x4 d = (f32x4){0.f, 0.f, 0.f, 0.f};
            const LAS unsigned char* Bb = L + L_KH + (16 * nt + fr) * 272 + fq * 16;
#pragma unroll
            for (int s = 0; s < 4; ++s) d = __builtin_amdgcn_mfma_f32_16x16x32_bf16(af[s], *(const LAS bf16x8*)(Bb + s * 64), d, 0, 0, 0);
            const int j = 16 * nt + fr; const float gj = GC[j];
#pragma unroll
            for (int r = 0; r < 4; ++r) { const int i = 16 * mt + 4 * fq + r; const float dec = __expf(fminf(GC[i] - gj, 0.f));
                if (sel == 0) ((LAS float*)(L + L_LM))[i * 64 + j] = (i > j) ? BETA[i] * d[r] * dec : 0.f;
                else { const float v = (i >= j) ? d[r] * dec : 0.f; ((bf16*)(dn + DN_QK))[i * 64 + permk(j)] = (bf16)(pk2(v, 0.f) & 0xffffu); } }
        }
    }
    __syncthreads();
    if (w < 4) {
        const int col = tid; const bool isu = col < 128; const int cc = col & 127;
        float x[64];
        if (isu) {
            LAS unsigned char* vb = L + L_VF + 4 * cc; asm volatile("" : "+v"(vb));
#pragma unroll
            for (int i = 0; i < 64; ++i) x[i] = *(const LAS float*)(vb + i * 528);
        } else {
            LAS unsigned char* kb = L + L_KH + 2 * cc; asm volatile("" : "+v"(kb));
#pragma unroll
            for (int i = 0; i < 64; ++i) x[i] = bf2f(*(const LAS bf16*)(kb + i * 272));
        }
        {
            LAS unsigned char* bb_ = L + L_BETA; asm volatile("" : "+v"(bb_));
#pragma unroll
            for (int i4 = 0; i4 < 16; ++i4) { const f32x4 bv = *(const LAS f32x4*)(bb_ + 16 * i4); f32x4 ev = *(const LAS f32x4*)(bb_ + 256 + 16 * i4); if (isu) ev = (f32x4){1.f, 1.f, 1.f, 1.f};
#pragma unroll
                for (int jj = 0; jj < 4; ++jj) x[4 * i4 + jj] *= bv[jj] * ev[jj]; }
        }
        asm volatile("" ::: "memory");
        LAS unsigned char* lmb = L + L_LM; asm volatile("" : "+v"(lmb));
        f32x4 lq[2][16];
        lq[1][0] = *(const LAS f32x4*)(lmb + 256);
#pragma unroll
        for (int i = 1; i < 64; ++i) {
            if (i + 1 < 64) {
#pragma unroll
                for (int j4 = 0; j4 < (i + 4) / 4; ++j4) lq[(i + 1) & 1][j4] = *(const LAS f32x4*)(lmb + (i + 1) * 256 + j4 * 16);
            }
            asm volatile("" ::: "memory");
            float r0 = x[i], r1 = 0.f, r2 = 0.f, r3 = 0.f;
#pragma unroll
            for (int j4 = 0; j4 < (i + 3) / 4; ++j4) { const f32x4 lv = lq[i & 1][j4];
                if (4 * j4 + 0 < i) r0 -= lv[0] * x[4 * j4 + 0];
                if (4 * j4 + 1 < i) r1 -= lv[1] * x[4 * j4 + 1];
                if (4 * j4 + 2 < i) r2 -= lv[2] * x[4 * j4 + 2];
                if (4 * j4 + 3 < i) r3 -= lv[3] * x[4 * j4 + 3]; }
            x[i] = (r0 + r1) + (r2 + r3);
        }
        if (isu) {
            const int es = cc >> 4, n = cc & 15;
#pragma unroll
            for (int q = 0; q < 16; ++q) { const int mt = q >> 2, rg = q & 3;
                u32x2 wv; wv.x = pk2(x[4 * q], x[4 * q + 1]); wv.y = pk2(x[4 * q + 2], x[4 * q + 3]);
                *(u32x2*)(dn + DN_U + (size_t)(((es * 4 + mt) * 64 + rg * 16 + n) * 4) * 2) = wv; }
        } else {
            const int pd = permk(cc);
#pragma unroll
            for (int i = 0; i < 64; ++i) ((bf16*)(dn + DN_W))[i * 128 + pd] = (bf16)(pk2(-x[i], 0.f) & 0xffffu);
        }
    } else {
        const int t2 = tid - 256;
        { const int d2 = t2 & 63, i0 = t2 >> 6; const int pd = permk(2 * d2);
#pragma unroll
          for (int k = 0; k < 16; ++k) { const int i = i0 + 4 * k; const unsigned qv = *(const LAS unsigned*)(L + L_QH + i * 272 + 4 * d2); const float e = EG[i];
              *(unsigned*)(dn + DN_QG + (size_t)(i * 128 + pd) * 2) = pk2(bflo(qv) * e, bfhi(qv) * e); } }
        { const int d = t2 & 127, hf = t2 >> 7; const float gl = GC[63];
#pragma unroll
          for (int q = 0; q < 8; ++q) { const int jq = hf * 8 + q;
              const int j0 = 32 * (jq >> 3) + 16 * (jq & 1) + 4 * ((jq >> 1) & 3);
              float kv[4];
#pragma unroll
              for (int r = 0; r < 4; ++r) kv[r] = bf2f(*(const LAS bf16*)(L + L_KH + (j0 + r) * 272 + 2 * d)) * __expf(gl - GC[j0 + r]);
              u32x2 wv; wv.x = pk2(kv[0], kv[1]); wv.y = pk2(kv[2], kv[3]);
              *(u32x2*)(dn + DN_KGT + (size_t)(d * 64 + 4 * jq) * 2) = wv; } }
    }
    __syncthreads();
}

__device__ __forceinline__ void s5_pass1(const Args& a, const Ctx& c, int g, int first, int stride) {
    const bf16* PROJ = (const bf16*)(a.ws + WS_PROJ);
    int l = c.lane; asm volatile("" : "+v"(l));
    const int col = l & 15, rg = l >> 4;
    f32x2 lamS, ccS; s5_state_params(a, g, l, lamS, ccS);
    S5W W; s5_setup(a, g, l, W, lamS, ccS);
    for (int k = first; k < NBP * 31; k += stride) {
        const int b = k / 31, ch = k % 31;
        const int tok0 = b * SEQ + ch * 64;
        u32x4 au[4];
#pragma unroll
        for (int st = 0; st < 4; ++st) au[st] = s5_load_u(PROJ, tok0 + 16 * st, g, 16, l);
        f32x2 hin[4];
#pragma unroll
        for (int j = 0; j < 4; ++j) hin[j] = (f32x2){0.f, 0.f};
#pragma unroll
        for (int st = 0; st < 4; ++st) {
            f32x4 d[8]; s5_bu_tile(au[st], W, d);
#pragma unroll
            for (int j = 0; j < 4; ++j) { f32x2 h[4]; s5_scan_block(W, j, rg, d[j], d[4 + j], hin[j], h); hin[j] = shfl2(h[3], 48 + col); }
        }
        const f32x2 ho = rg == 0 ? hin[0] : rg == 1 ? hin[1] : rg == 2 ? hin[2] : hin[3];
        *(f32x2*)(a.ws + WS_E + ((size_t)((b * NCH + ch) * NG + g) * 64 + l) * 8) = ho;
    }
}

__device__ __forceinline__ void s5_pass2(const Args& a, const Ctx& c, int g, int first, int stride, int vend) {
    const bf16* PROJ = (const bf16*)(a.ws + WS_PROJ);
    bf16* YG = (bf16*)(a.ws + WS_YG);
    LAS unsigned char* hb = c.lds + c.wave * 8192;
    int l = c.lane; asm volatile("" : "+v"(l));
    const int fr = l & 15, fq = l >> 4, col = fr, rg = fq;
    f32x2 lamS, ccS; s5_state_params(a, g, l, lamS, ccS);
    f32x2 pw64 = lamS;
#pragma unroll
    for (int q = 0; q < 6; ++q) pw64 = cmul(pw64, pw64);
    S5W W; s5_setup(a, g, l, W, lamS, ccS);
    bf16x8 cf[4];
#pragma unroll
    for (int s = 0; s < 4; ++s) { const int n0 = 16 * s + 4 * fq;
        const f32x4 vr = *(const f32x4*)(a.in[I_S5CR] + (size_t)(g * 16 + fr) * 64 + n0), vi = *(const f32x4*)(a.in[I_S5CI] + (size_t)(g * 16 + fr) * 64 + n0);
        cf[s] = __builtin_bit_cast(bf16x8, pack8((f32x4){vr[0], -vi[0], vr[1], -vi[1]}, (f32x4){vr[2], -vi[2], vr[3], -vi[3]})); }
    const float dsk = a.in[I_S5D][g * 16 + fr];
    for (int v = first; v < vend; v += stride) {
        const int k = (v & 1) ? 128 + (v >> 1) : (v >> 1);
        const bool prompt = k < 128;
        int tok0, nsub, nvalid, b = 0, ch = 0, sq = 0;
        if (prompt) { ch = k & 31; b = k >> 5; tok0 = b * SEQ + ch * 64; nsub = 4; nvalid = 16; }
        else { sq = k - 128; tok0 = TP + sq * LSM; nsub = 1; nvalid = LSM; }
        u32x4 au[4];
#pragma unroll
        for (int st = 0; st < 4; ++st) { au[st] = (u32x4){0u, 0u, 0u, 0u}; if (st < nsub) au[st] = s5_load_u(PROJ, tok0 + 16 * st, g, nvalid, l); }
        f32x2 hs = (f32x2){0.f, 0.f};
        if (prompt) {
            const f32x2* E = (const f32x2*)(a.ws + WS_E) + ((size_t)(b * NCH) * NG + g) * 64 + l;
            for (int j0 = 0; j0 < ch; j0 += 16) {
                f32x2 ev[16];
#pragma unroll
                for (int j = 0; j < 16; ++j) { ev[j] = (f32x2){0.f, 0.f}; if (j0 + j < ch) ev[j] = E[(size_t)(j0 + j) * NG * 64]; }
#pragma unroll
                for (int j = 0; j < 16; ++j) if (j0 + j < ch) hs = cfma(pw64, hs, ev[j]);
            }
        } else {
            hs = (f32x2){a.in[I_S5RE][(size_t)(sq * NG + g) * 64 + l], a.in[I_S5IM][(size_t)(sq * NG + g) * 64 + l]};
        }
        f32x2 hin[4];
#pragma unroll
        for (int j = 0; j < 4; ++j) hin[j] = shfl2(hs, 16 * j + col);
        const int endsrc = ((nvalid - 1) >> 2) * 16 + col;
#pragma unroll
        for (int st = 0; st < 4; ++st) {
            if (st < nsub) {
            f32x4 d[8]; s5_bu_tile(au[st], W, d);
            if (fq < 2) *(LAS u32x4*)(hb + 4608 + fr * 32 + fq * 16) = au[st];
#pragma unroll
            for (int j = 0; j < 4; ++j) { f32x2 h[4]; s5_scan_block(W, j, rg, d[j], d[4 + j], hin[j], h); hin[j] = shfl2(h[3], endsrc);
#pragma unroll
                for (int i = 0; i < 4; ++i) *(LAS unsigned*)(hb + (4 * rg + i) * 272 + 4 * (16 * j + col)) = pk2(h[i][0], h[i][1]); }
            LDS_WAIT(); asm volatile("" ::: "memory");
            f32x4 y = (f32x4){0.f, 0.f, 0.f, 0.f};
#pragma unroll
            for (int s = 0; s < 4; ++s) y = __builtin_amdgcn_mfma_f32_16x16x32_bf16(*(const LAS bf16x8*)(hb + fr * 272 + s * 64 + fq * 16), cf[s], y, 0, 0, 0);
#pragma unroll
            for (int r = 0; r < 4; ++r) { const int t = 4 * fq + r;
                if (t < nvalid) { const float v = y[r] + dsk * bf2f(*(const LAS bf16*)(hb + 4608 + t * 32 + fr * 2)); YG[(size_t)(tok0 + 16 * st + t) * 1024 + g * 16 + fr] = (bf16)(pk2(gelu_tanh(v), 0.f) & 0xffffu); } }
            LDS_WAIT(); asm volatile("" ::: "memory");
            }
        }
        const f32x2 ho = rg == 0 ? hin[0] : rg == 1 ? hin[1] : rg == 2 ? hin[2] : hin[3];
        if (prompt) { if (ch == 31) { a.out[O_S5RP + (size_t)(b * NG + g) * 64 + l] = ho[0]; a.out[O_S5IP + (size_t)(b * NG + g) * 64 + l] = ho[1]; } }
        else { a.out[O_S5RS + (size_t)(sq * NG + g) * 64 + l] = ho[0]; a.out[O_S5IS + (size_t)(sq * NG + g) * 64 + l] = ho[1]; }
    }
}

constexpr int Q_W = 0, Q_QG = 17408, Q_KGT = 34816, Q_QK = 53248;
__device__ __forceinline__ void dn_sequential(const Args& a, const Ctx& c, int bh) {
    int tid = c.tid; asm volatile("" : "+v"(tid));
    const int b = bh >> 3, h = bh & 7, es = __builtin_amdgcn_readfirstlane(tid >> 6), l = tid & 63, fr = l & 15, fq = l >> 4;
    LAS unsigned char* L = c.lds;
    float* O = (float*)(a.ws + WS_O);
    const float* GL = (const float*)(a.ws + WS_GL);
    f32x4 S[8];
#pragma unroll
    for (int i = 0; i < 8; ++i) S[i] = (f32x4){0.f, 0.f, 0.f, 0.f};
    constexpr int QBUF = 62464;
    u32x4 pw[2], pq[2], pk_[2], pqk; u32x2 uu[4]; float gl;
#define DNQ_LOAD(chn) do { const int item_ = (b * NCH + (chn)) * NH + h; const unsigned char* dn_ = (const unsigned char*)a.out + (size_t)item_ * DN_ITEM; \
        _Pragma("unroll") for (int q = 0; q < 2; ++q) { const int p = tid + 512 * q; pw[q] = *(const u32x4*)(dn_ + DN_W + (size_t)p * 16); pq[q] = *(const u32x4*)(dn_ + DN_QG + (size_t)p * 16); pk_[q] = *(const u32x4*)(dn_ + DN_KGT + (size_t)p * 16); } \
        pqk = *(const u32x4*)(dn_ + DN_QK + (size_t)tid * 16); \
        _Pragma("unroll") for (int mt = 0; mt < 4; ++mt) uu[mt] = *(const u32x2*)(dn_ + DN_U + (size_t)(((es * 4 + mt) * 64 + l) * 4) * 2); \
        gl = GL[item_]; } while (0)
#define DNQ_STORE(Lb) do { \
        _Pragma("unroll") for (int q = 0; q < 2; ++q) { const int p = tid + 512 * q; *(LAS u32x4*)((Lb) + Q_W + (p >> 4) * 272 + (p & 15) * 16) = pw[q]; *(LAS u32x4*)((Lb) + Q_QG + (p >> 4) * 272 + (p & 15) * 16) = pq[q]; \
            *(LAS u32x4*)((Lb) + Q_KGT + (p >> 3) * 144 + (p & 7) * 16) = pk_[q]; } \
        *(LAS u32x4*)((Lb) + Q_QK + (tid >> 3) * 144 + (tid & 7) * 16) = pqk; } while (0)
    DNQ_LOAD(0);
    DNQ_STORE(L);
    __syncthreads();
    for (int ch = 0; ch < NCH; ++ch) {
        LAS unsigned char* Lc = L + (ch & 1) * QBUF;
        const u32x2 uc0 = uu[0], uc1 = uu[1], uc2 = uu[2], uc3 = uu[3]; const float glc = gl;
        if (ch + 1 < NCH) DNQ_LOAD(ch + 1);
        bf16x8 Sb[4];
#pragma unroll
        for (int s = 0; s < 4; ++s) Sb[s] = __builtin_bit_cast(bf16x8, pack8(S[2 * s], S[2 * s + 1]));
        f32x4 vn[4];
#pragma unroll
        for (int mt = 0; mt < 4; ++mt) {
            const u32x2 ucm = mt == 0 ? uc0 : mt == 1 ? uc1 : mt == 2 ? uc2 : uc3;
            f32x4 acc = (f32x4){bflo(ucm.x), bfhi(ucm.x), bflo(ucm.y), bfhi(ucm.y)};
#pragma unroll
            for (int s = 0; s < 4; ++s) acc = __builtin_amdgcn_mfma_f32_16x16x32_bf16(*(const LAS bf16x8*)(Lc + Q_W + (16 * mt + fr) * 272 + s * 64 + fq * 16), Sb[s], acc, 0, 0, 0);
            vn[mt] = acc;
        }
        bf16x8 vb[2];
        vb[0] = __builtin_bit_cast(bf16x8, pack8(vn[0], vn[1])); vb[1] = __builtin_bit_cast(bf16x8, pack8(vn[2], vn[3]));
#pragma unroll
        for (int mt = 0; mt < 4; ++mt) {
            f32x4 acc = (f32x4){0.f, 0.f, 0.f, 0.f};
#pragma unroll
            for (int s = 0; s < 4; ++s) acc = __builtin_amdgcn_mfma_f32_16x16x32_bf16(*(const LAS bf16x8*)(Lc + Q_QG + (16 * mt + fr) * 272 + s * 64 + fq * 16), Sb[s], acc, 0, 0, 0);
#pragma unroll
            for (int s = 0; s < 2; ++s) acc = __builtin_amdgcn_mfma_f32_16x16x32_bf16(*(const LAS bf16x8*)(Lc + Q_QK + (16 * mt + fr) * 144 + s * 64 + fq * 16), vb[s], acc, 0, 0, 0);
            const int tok = b * SEQ + ch * 64 + 16 * mt + 4 * fq;
#pragma unroll
            for (int r = 0; r < 4; ++r) O[(size_t)(tok + r) * 1024 + h * 128 + es * 16 + fr] = acc[r];
        }
#pragma unroll
        for (int dt = 0; dt < 8; ++dt) {
            f32x4 acc = S[dt] * glc;
#pragma unroll
            for (int s = 0; s < 2; ++s) acc = __builtin_amdgcn_mfma_f32_16x16x32_bf16(*(const LAS bf16x8*)(Lc + Q_KGT + (16 * dt + fr) * 144 + s * 64 + fq * 16), vb[s], acc, 0, 0, 0);
            S[dt] = acc;
        }
        if (ch + 1 < NCH) DNQ_STORE(L + ((ch + 1) & 1) * QBUF);
        __syncthreads();
    }
#undef DNQ_LOAD
#undef DNQ_STORE
    float* SO = a.out + O_DELTAP + (size_t)(b * NH + h) * HD * HD;
#pragma unroll
    for (int dt = 0; dt < 8; ++dt)
#pragma unroll
        for (int r = 0; r < 4; ++r) SO[(size_t)(16 * dt + 4 * fq + r) * HD + es * 16 + fr] = S[dt][r];
}

__device__ __forceinline__ void dn_sample(const Args& a, const Ctx& c, int item, bool valid) {
    int tid = c.tid; asm volatile("" : "+v"(tid));
    const int wave = __builtin_amdgcn_readfirstlane(tid >> 6), lane = tid & 63;
    const int il = wave >> 1, e = tid & 127, wv = wave & 1;
    const int sq = item >> 3, h = item & 7;
    const bf16* PROJ = (const bf16*)(a.ws + WS_PROJ);
    const float* BA = (const float*)(a.ws + WS_BA);
    LAS float* QS = (LAS float*)(c.lds + il * 8192);
    LAS float* KS = (LAS float*)(c.lds + il * 8192 + 4096);
    LAS float* RED = (LAS float*)(c.lds + 32768 + il * 256);
    float qv[8], kv[8], vv[8];
    float S[128];
    if (valid) {
#pragma unroll
        for (int p = 0; p < 3; ++p) {
            const int cch = p * 1024 + h * 128 + e;
            float wt[4];
#pragma unroll
            for (int j = 0; j < 4; ++j) wt[j] = a.in[I_CONVW][j * CONVC + cch];
            float xr[11];
#pragma unroll
            for (int i = 0; i < 3; ++i) xr[i] = a.in[I_SCONV][(size_t)(sq * 3 + i) * CONVC + cch];
#pragma unroll
            for (int i = 0; i < 8; ++i) xr[3 + i] = bf2f(PROJ[(size_t)(TP + sq * LSM + i) * NPROJ + 1024 + cch]);
#pragma unroll
            for (int t = 0; t < 8; ++t) { const float s = siluf_(xr[t] * wt[0] + xr[t + 1] * wt[1] + xr[t + 2] * wt[2] + xr[t + 3] * wt[3]);
                if (p == 0) qv[t] = s; else if (p == 1) kv[t] = s; else vv[t] = s; }
        }
#pragma unroll
        for (int t = 0; t < 8; ++t) { const float s1 = wave_sum(qv[t] * qv[t]), s2 = wave_sum(kv[t] * kv[t]); if (lane == 0) { RED[wv * 16 + t] = s1; RED[wv * 16 + 8 + t] = s2; } }
    }
    __syncthreads();
    if (valid) {
#pragma unroll
        for (int t = 0; t < 8; ++t) { const float sq_ = RED[t] + RED[16 + t], sk_ = RED[8 + t] + RED[24 + t];
            QS[t * 128 + e] = qv[t] * __builtin_amdgcn_rsqf(sq_ + EPS) * 0.08838834764831845f; KS[t * 128 + e] = kv[t] * __builtin_amdgcn_rsqf(sk_ + EPS); }
    }
    __syncthreads();
    if (valid) {
        { const float* S0 = a.in[I_SDELTA] + (size_t)item * HD * HD + e;
#pragma unroll
          for (int d = 0; d < 128; ++d) S[d] = __builtin_nontemporal_load(S0 + (size_t)d * HD); }
        float* O = (float*)(a.ws + WS_O);
        const float alog = __expf(a.in[I_ALOG][h]), dtb = a.in[I_DTB][h];
        for (int t = 0; t < 8; ++t) {
            const int tok = TP + sq * LSM + t;
            const float beta = sigmoidf_(BA[(size_t)tok * 16 + h]); const float xx = BA[(size_t)tok * 16 + 8 + h] + dtb;
            const float aa = __expf(-alog * (fmaxf(xx, 0.f) + log1pf(__expf(-fabsf(xx)))));
            const LAS f32x4* kq = (const LAS f32x4*)(KS + t * 128); const LAS f32x4* qq = (const LAS f32x4*)(QS + t * 128);
            float ks0 = 0.f, ks1 = 0.f, ks2 = 0.f, ks3 = 0.f;
#pragma unroll
            for (int d8 = 0; d8 < 4; ++d8) {
#pragma unroll
                for (int dd = 0; dd < 8; ++dd) { const int d4 = 8 * d8 + dd; const f32x4 k4 = kq[d4]; ks0 += S[4 * d4] * k4[0]; ks1 += S[4 * d4 + 1] * k4[1]; ks2 += S[4 * d4 + 2] * k4[2]; ks3 += S[4 * d4 + 3] * k4[3]; }
                asm volatile("" ::: "memory"); }
            const float vnew = beta * (vv[t] - aa * ((ks0 + ks1) + (ks2 + ks3)));
            float o0 = 0.f, o1 = 0.f, o2 = 0.f, o3 = 0.f;
#pragma unroll
            for (int d8 = 0; d8 < 8; ++d8) {
#pragma unroll
                for (int dd = 0; dd < 4; ++dd) { const int d4 = 4 * d8 + dd; const f32x4 k4 = kq[d4], q4 = qq[d4];
                    float sn;
                    sn = aa * S[4 * d4 + 0] + k4[0] * vnew; S[4 * d4 + 0] = sn; o0 += sn * q4[0];
                    sn = aa * S[4 * d4 + 1] + k4[1] * vnew; S[4 * d4 + 1] = sn; o1 += sn * q4[1];
                    sn = aa * S[4 * d4 + 2] + k4[2] * vnew; S[4 * d4 + 2] = sn; o2 += sn * q4[2];
                    sn = aa * S[4 * d4 + 3] + k4[3] * vnew; S[4 * d4 + 3] = sn; o3 += sn * q4[3]; }
                asm volatile("" ::: "memory"); }
            const float o = (o0 + o1) + (o2 + o3);
            O[(size_t)tok * 1024 + h * 128 + e] = o;
        }
        float* SO = a.out + O_DELTAS + (size_t)item * HD * HD + e;
#pragma unroll
        for (int d = 0; d < 128; ++d) __builtin_nontemporal_store(S[d], SO + (size_t)d * HD);
    }
    __syncthreads();
}

__device__ __forceinline__ void reduce_sample_rows(const Ctx& c, const float* base, const float* slab, float* XO, bf16* XG, const float* gw, float* ssq) {
    for (int r = c.blk * 8 + c.wave; r < TS; r += c.G * 8) {
        float s = 0.f;
#pragma unroll 2
        for (int j = 0; j < 8; ++j) { const int col = 4 * (c.lane + 64 * j);
            f32x4 v = ldnt4(base + (size_t)r * DM + col);
#pragma unroll
            for (int kc = 0; kc < 8; ++kc) v += ldnt4(slab + ((size_t)kc * TS + r) * DM + col);
            *(f32x4*)(XO + (size_t)r * DM + col) = v;
            const f32x4 gq = *(const f32x4*)(gw + col); const f32x4 o = v * gq;
            u32x2 w; w.x = pk2(o[0], o[1]); w.y = pk2(o[2], o[3]); *(u32x2*)(XG + (size_t)r * DM + col) = w;
            s += (v[0] * v[0] + v[1] * v[1]) + (v[2] * v[2] + v[3] * v[3]); }
        s = wave_sum(s); if (c.lane == 0) ssq[r] = s;
    }
}

__global__ void __launch_bounds__(512, 2) fwd_megakernel(Args args) {
    extern __shared__ __attribute__((aligned(16))) unsigned char lds_raw[];
    Ctx c; c.lds = (LAS unsigned char*)lds_raw; c.tid = threadIdx.x; c.lane = c.tid & 63; c.wave = __builtin_amdgcn_readfirstlane(c.tid >> 6); c.G = gridDim.x; c.blk = blockIdx.x;
    volatile LAS unsigned* MISC = (volatile LAS unsigned*)(c.lds + MISC_OFF);
    unsigned char* ws = args.ws;
    unsigned* ctl = (unsigned*)(ws + WS_CTL);
    for (int u = c.tid; u < (LDS_BYTES - RING_BYTES) / 4; u += 512) ((LAS unsigned*)(c.lds + RING_BYTES))[u] = 0u;
    __syncthreads();
    XcdBarrier bar; bar.bar = ctl + CW_BAR; bar.x = 0; bar.st = nullptr;
    if (MK_N_LAUNCHES == 1) bar = xcd_barrier_post(ctl + CW_BAR, MISC + 8);
    const int lo = args.ph_lo, hi = args.ph_hi;
#ifndef PH_MASK
#define PH_MASK 0x1fff
#endif
#define IN(k) (((PH_MASK >> (k)) & 1) && lo <= (k) && (k) < hi)
#ifndef REP_MASK
#define REP_MASK 0
#endif
#define PHASE(k) for (int rep_ = 0; IN(k) && rep_ <= ((REP_MASK >> (k)) & 1); ++rep_)
#define REPSYNC() do { if (rep_) xcd_barrier(bar); } while (0)
#define SEAM(k) do { if (IN(k) && IN((k) + 1)) xcd_barrier(bar); } while (0)
    bf16* PROJ = (bf16*)(ws + WS_PROJ);
    float* ssq1 = (float*)(ctl + CW_SSQ1); float* ssq2 = (float*)(ctl + CW_SSQ2); float* ssq3 = (float*)(ctl + CW_SSQ3);
    float* Y = args.out + O_Y;

    PHASE(0) { REPSYNC(); phase0(args, c); } SEAM(0);
    PHASE(1) { REPSYNC();
        if (c.blk < P1_GEMM_WGS) {
            pg8::Gemm g{(const bf16*)(ws + WS_HB), (const bf16*)(ws + WS_WIN), TT, NINP, DM}; pg8::StaticOrder S; S.init(TT, NINP, P1_GEMM_WGS, c.blk);
            EpiProj E{PROJ, (float*)(ws + WS_BA)};
            pg8::gemm_phase<EpiProj, pg8::StaticOrder>(c.lds, g, S, E);
        } else conv_range(args, c, CV_EARLY, CV_ALL, (c.blk - P1_GEMM_WGS) * 8 + c.wave, (c.G - P1_GEMM_WGS) * 8);
    } SEAM(1);
    PHASE(2) { REPSYNC();
#ifndef REPX
#define REPX 0
#endif
        for (int rx = 0; rx <= ((REPX >> 0) & 1); ++rx)
        for (int it = c.blk; it < NBP * NCH * NH; it += c.G) dn_precompute(args, c, it);
        __syncthreads();
        for (int rx = 0; rx <= ((REPX >> 1) & 1); ++rx)
        { const int wi = c.blk * 8 + c.wave; s5_pass1(args, c, wi & 63, wi >> 6, (c.G * 8) >> 6); }
        for (int i = c.blk * 512 + c.tid; i < (NBP + NSB) * 3 * CONVC; i += c.G * 512) {
            const int cc = i % CONVC, rr = (i / CONVC) % 3, sq = i / (3 * CONVC);
            if (sq < NBP) args.out[O_CONVP + (size_t)(sq * 3 + rr) * CONVC + cc] = bf2f(PROJ[(size_t)(sq * SEQ + SEQ - 3 + rr) * NPROJ + 1024 + cc]);
            else { const int s2 = sq - NBP; args.out[O_CONVS + (size_t)(s2 * 3 + rr) * CONVC + cc] = bf2f(PROJ[(size_t)(TP + s2 * LSM + LSM - 3 + rr) * NPROJ + 1024 + cc]); }
        }
    } SEAM(2);
    PHASE(3) { REPSYNC();
        if (c.blk < 32) { for (int rx = 0; rx <= ((REPX >> 2) & 1); ++rx) dn_sequential(args, c, c.blk); }
        else {
            const int nb = c.G - 32, rb = c.blk - 32;
            for (int rx = 0; rx <= ((REPX >> 3) & 1); ++rx) {
                { const int it = rb * 4 + (c.wave >> 1); dn_sample(args, c, it, true); }
                if (rb < 32) { const int it = nb * 4 + rb * 4 + (c.wave >> 1); dn_sample(args, c, it, it < NSB * NH); }
            }
            __syncthreads();
            for (int rx = 0; rx <= ((REPX >> 4) & 1); ++rx)
            { const int wi = rb * 8 + c.wave, slot = wi >> 6;
              if (slot < 4) s5_pass2(args, c, wi & 63, slot, 4, 8); else s5_pass2(args, c, wi & 63, 8 + slot - 4, 24, 256); }
        }
    } SEAM(3);
    PHASE(4) { REPSYNC();
        if (c.blk < 144) {
            pg8::Gemm g{(const bf16*)(ws + WS_YG), (const bf16*)(ws + WS_WGLU), TT, 1024, 1024}; pg8::StaticOrder S; S.init(TT, 1024, 144, c.blk);
            EpiGlu E{(const bf16*)(ws + WS_YG), (bf16*)(ws + WS_YCAT), args.in[I_BGLU]};
            pg8::gemm_phase<EpiGlu, pg8::StaticOrder>(c.lds, g, S, E);
        } else {
            const float* O = (const float*)(ws + WS_O); bf16* YDN = (bf16*)(ws + WS_YCAT) + 1024;
            const f32x2 ow = *(const f32x2*)(args.in[I_ONORM] + 2 * c.lane);
            for (int tok = (c.blk - 144) * 8 + c.wave; tok < TT; tok += (c.G - 144) * 8) {
                const float* orow = O + (size_t)tok * 1024 + 2 * c.lane; const bf16* zrow = PROJ + (size_t)tok * NPROJ + 4096 + 2 * c.lane; bf16* yrow = YDN + (size_t)tok * DM + 2 * c.lane;
                f32x2 o[8]; unsigned zz[8];
#pragma unroll
                for (int h = 0; h < 8; ++h) { o[h] = *(const f32x2*)(orow + h * 128); zz[h] = *(const unsigned*)(zrow + h * 128); }
#pragma unroll
                for (int h = 0; h < 8; ++h) {
                    const float rs = __builtin_amdgcn_rsqf(wave_sum(o[h][0] * o[h][0] + o[h][1] * o[h][1]) * (1.f / HD) + EPS);
                    *(unsigned*)(yrow + h * 128) = pk2(o[h][0] * rs * ow[0] * siluf_(bflo(zz[h])), o[h][1] * rs * ow[1] * siluf_(bfhi(zz[h])));
                }
            }
        }
    } SEAM(4);
    PHASE(5) { REPSYNC();
        pg8::Gemm g{(const bf16*)(ws + WS_YCAT), (const bf16*)(ws + WS_WA), TT, DM, DM, 0}; pg8::StaticOrder S; S.init(TT, DM, c.G, c.blk);
        EpiMix E{PROJ, (bf16*)(ws + WS_MIX)}; pg8::gemm_phase<EpiMix, pg8::StaticOrder>(c.lds, g, S, E);
    } SEAM(5);
    PHASE(6) { REPSYNC();
        { pg8::Gemm g{(const bf16*)(ws + WS_MIX), (const bf16*)(ws + WS_WOUT), TP, DM, DM, 0}; pg8::StaticOrder S; S.init(TP, DM, c.G, c.blk);
          EpiResid E{args.in[I_XP], args.in[I_XS], (float*)(ws + WS_X1), (bf16*)(ws + WS_X1G), args.in[I_GFFN], ssq1};
          pg8::gemm_phase<EpiResid, pg8::StaticOrder>(c.lds, g, S, E); }
        { const int kc = c.blk & 7;
          pg8::Gemm g{(const bf16*)(ws + WS_MIX) + kc * 256, (const bf16*)(ws + WS_WOUT) + kc * 256, TT, DM, 256, DM}; TailOrder S{c.blk};
          EpiSlab E{Y + (size_t)kc * TS * DM};
          pg8::gemm_phase<EpiSlab, TailOrder>(c.lds, g, S, E); }
    } SEAM(6);
    PHASE(7) { REPSYNC();
        reduce_sample_rows(c, args.in[I_XS], Y, (float*)(ws + WS_X1) + (size_t)TP * DM, (bf16*)(ws + WS_X1G) + (size_t)TP * DM, args.in[I_GFFN], ssq1 + TP);
    } SEAM(7);
    PHASE(8) { REPSYNC();
        pg8::Gemm g{(const bf16*)(ws + WS_X1G), (const bf16*)(ws + WS_WGU), TT, 2 * FF, DM}; pg8::StaticOrder S; S.init(TT, 2 * FF, c.G, c.blk);
        EpiGU E{ssq1, (bf16*)(ws + WS_ACT)};
        pg8::gemm_phase<EpiGU, pg8::StaticOrder>(c.lds, g, S, E);
    } SEAM(8);
    PHASE(9) { REPSYNC();
        const float* x1 = (const float*)(ws + WS_X1);
        { pg8::Gemm g{(const bf16*)(ws + WS_ACT), (const bf16*)(ws + WS_WDOWN), TP, DM, FF, 0}; pg8::StaticOrder S; S.init(TP, DM, c.G, c.blk);
          EpiResid E{x1, x1 + (size_t)TP * DM, Y, (bf16*)(ws + WS_X2G), args.in[I_GPLE], ssq2};
          pg8::gemm_phase<EpiResid, pg8::StaticOrder>(c.lds, g, S, E); }
        { const int kc = c.blk & 7, kt0 = (kc >> 1) * 22 + (kc & 1) * 12, nkt = (kc & 1) ? 10 : 12;
          pg8::Gemm g{(const bf16*)(ws + WS_ACT) + kt0 * 64, (const bf16*)(ws + WS_WDOWN) + kt0 * 64, TT, DM, nkt * 64, FF}; TailOrder S{c.blk};
          EpiSlab E{(float*)(ws + WS_SLAB) + (size_t)kc * TS * DM};
          pg8::gemm_phase<EpiSlab, TailOrder>(c.lds, g, S, E); }
    } SEAM(9);
    PHASE(10) { REPSYNC();
        reduce_sample_rows(c, (const float*)(ws + WS_X1) + (size_t)TP * DM, (const float*)(ws + WS_SLAB), Y + (size_t)TP * DM, (bf16*)(ws + WS_X2G) + (size_t)TP * DM, args.in[I_GPLE], ssq2 + TP);
        { pg8::Gemm g{(const bf16*)(ws + WS_PB), (const bf16*)(ws + WS_WPLE), TT, DM, PLE, 0}; pg8::StaticOrder S; S.init(TT, DM, c.G, c.blk);
          EpiF32 E{(float*)(ws + WS_TPLE)}; pg8::gemm_phase<EpiF32, pg8::StaticOrder>(c.lds, g, S, E); }
    } SEAM(10);
    PHASE(11) { REPSYNC();
        { pg8::Gemm g{(const bf16*)(ws + WS_X2G), (const bf16*)(ws + WS_WPG), TP, DM, DM, 0}; pg8::StaticOrder S; S.init(TP, DM, c.G, c.blk);
          EpiPleB E{Y, (const float*)(ws + WS_TPLE), ssq2, ssq3}; pg8::gemm_phase<EpiPleB, pg8::StaticOrder>(c.lds, g, S, E); }
        { const int kc = c.blk & 7;
          pg8::Gemm g{(const bf16*)(ws + WS_X2G) + kc * 256, (const bf16*)(ws + WS_WPG) + kc * 256, TT, DM, 256, DM}; TailOrder S{c.blk};
          EpiSlab E{(float*)(ws + WS_SLAB) + (size_t)kc * TS * DM};
          pg8::gemm_phase<EpiSlab, TailOrder>(c.lds, g, S, E); }
    } SEAM(11);
    PHASE(12) { REPSYNC();
        for (int m = c.blk * 8 + c.wave; m < TT; m += c.G * 8) {
            f32x4* yr = (f32x4*)(Y + (size_t)m * DM);
            if (m < TP) {
                const float rs = 1.f / sqrtf(ssq3[m] * (1.f / DM) + EPS);
#pragma unroll
                for (int j = 0; j < 8; ++j) { const f32x4 gq = ((const f32x4*)args.in[I_GFIN])[c.lane + 64 * j]; __builtin_nontemporal_store(__builtin_nontemporal_load(yr + c.lane + 64 * j) * gq * rs, yr + c.lane + 64 * j); }
            } else {
                const int r = m - TP; const float rs2 = __builtin_amdgcn_rsqf(ssq2[m] * (1.f / DM) + EPS);
                const f32x4* tp = (const f32x4*)((const float*)(ws + WS_TPLE) + (size_t)m * DM);
                f32x4 x3[8]; float sq = 0.f;
#pragma unroll
                for (int j = 0; j < 8; ++j) { const int q = c.lane + 64 * j;
                    f32x4 v = (f32x4){0.f, 0.f, 0.f, 0.f};
#pragma unroll
                    for (int kc = 0; kc < 8; ++kc) v += ((const f32x4*)((const float*)(ws + WS_SLAB) + ((size_t)kc * TS + r) * DM))[q];
                    x3[j] = yr[q] + tp[q] * sig4(v * rs2);
                    sq += (x3[j][0] * x3[j][0] + x3[j][1] * x3[j][1]) + (x3[j][2] * x3[j][2] + x3[j][3] * x3[j][3]); }
                const float rs = 1.f / sqrtf(wave_sum(sq) * (1.f / DM) + EPS);
#pragma unroll
                for (int j = 0; j < 8; ++j) { const f32x4 gq = ((const f32x4*)args.in[I_GFIN])[c.lane + 64 * j]; __builtin_nontemporal_store(x3[j] * gq * rs, yr + c.lane + 64 * j); }
            }
        }
    }
#undef IN
#undef SEAM
}

extern "C" void kernel_launch(void* const* d_in, const int* in_sizes, int n_in, void* d_out, int out_size, void* d_ws, size_t ws_size, hipStream_t stream) {
    static int grid = 0;
    if (grid == 0) {
        if (n_in != 35 || out_size != (int)O_END || ws_size < WS_END) { fprintf(stderr, "kernel_launch: unexpected problem (n_in %d out %d ws %zu)\n", n_in, out_size, ws_size); grid = -1; return; }
        int dev = 0, cus = 0, per_cu = 0;
        if (hipGetDevice(&dev) != hipSuccess || hipDeviceGetAttribute(&cus, hipDeviceAttributeMultiprocessorCount, dev) != hipSuccess) { grid = -1; return; }
        if (hipFuncSetAttribute((const void*)fwd_megakernel, hipFuncAttributeMaxDynamicSharedMemorySize, LDS_BYTES) != hipSuccess) { fprintf(stderr, "kernel_launch: hipFuncSetAttribute failed\n"); grid = -1; return; }
        if (hipOccupancyMaxActiveBlocksPerMultiprocessor(&per_cu, (const void*)fwd_megakernel, 512, LDS_BYTES) != hipSuccess || per_cu < 1) { fprintf(stderr, "kernel_launch: occupancy query reports %d\n", per_cu); (void)hipGetLastError(); grid = -1; return; }
        grid = cus;
        if (grid != 256) { fprintf(stderr, "kernel_launch: unsupported CU count %d\n", cus); grid = -1; return; }
    }
    if (grid < 0) return;
    (void)hipMemsetAsync((char*)d_ws + WS_CTL, 0, CTL_ZERO_BYTES, stream);
    Args a{};
    for (int i = 0; i < 35; ++i) a.in[i] = (const float*)d_in[i];
    a.out = (float*)d_out; a.ws = (unsigned char*)d_ws;
    if (MK_N_LAUNCHES == 1) {
        a.ph_lo = 0; a.ph_hi = 13; a.li = 0;
        void* kargs[] = {&a};
        hipError_t e = hipLaunchCooperativeKernel((const void*)fwd_megakernel, dim3(grid), dim3(512), kargs, LDS_BYTES, stream);
        if (e != hipSuccess) fprintf(stderr, "kernel_launch: cooperative launch failed: %s\n", hipGetErrorString(e));
    } else {
        for (int p = 0; p < 13; ++p) { a.ph_lo = p; a.ph_hi = p + 1; a.li = p; hipLaunchKernelGGL(fwd_megakernel, dim3(grid), dim3(512), LDS_BYTES, stream, a); }
    }
}
```
